# Optimizing an MI355X kernel written in HIP

```python
import jax, jax.numpy as jnp
from jax import lax
import numpy as np

D_MODEL = 1024
BATCH = 16
SEQ = 256
DEPTH = 2
DEC_BATCH = 8
DEC_SEQ = 1024
PAST_LEN = 256

GRID_W = 64
N_BRANCH = 4
BRANCH_W = D_MODEL // N_BRANCH
CHUNK = 64
Q_BLOCK = 128
D_FF = 2816
N_MOD = 9
RMS_EPS = 1e-6
A_N = 64
A_HEADS = BRANCH_W // A_N
A_W = A_HEADS * A_N
A_LORA_W = 64
A_LORA_A = 64
A_LORA_G = 160
A_GN_EPS = 64e-5
A_SIZES = (A_W, A_W, A_W, A_LORA_W, A_LORA_W, A_LORA_A, A_LORA_A, A_LORA_G)
A_COLS = 3 * A_W + 2 * A_LORA_W + 2 * A_LORA_A + A_LORA_G
B_HEADS = 4
B_DK = BRANCH_W // (2 * B_HEADS)
B_DV = BRANCH_W // B_HEADS
B_LORA = 16
GLA_TAU = 16.0
B_QK = B_HEADS * B_DK
B_V = B_HEADS * B_DV
B_SIZES = (B_QK, B_QK, B_V, B_LORA, B_LORA, B_V)
B_COLS = 2 * B_QK + 2 * B_V + 2 * B_LORA
C_HEADS = 4
C_DK = BRANCH_W // C_HEADS
C_DV = BRANCH_W // C_HEADS
CONV_W = 3
C_QKV = C_HEADS * (2 * C_DK + C_DV)
C_V = C_HEADS * C_DV
C_SIZES = (C_QKV, C_V, C_HEADS, C_HEADS, C_HEADS, C_HEADS)
C_COLS = C_QKV + C_V + 4 * C_HEADS
D_HD = 64
D_HEADS = BRANCH_W // D_HD
D_KV_HEADS = D_HEADS // 2
ROPE_THETA = 10000.0
D_SIZES = (D_HEADS * D_HD, D_KV_HEADS * D_HD, D_KV_HEADS * D_HD)
D_COLS = (D_HEADS + 2 * D_KV_HEADS) * D_HD
GATE_COLS = N_BRANCH * D_MODEL
BLOCK_SIZES = (A_COLS, B_COLS, C_COLS, D_COLS, GATE_COLS)
N_IN = A_COLS + B_COLS + C_COLS + D_COLS + GATE_COLS

kernel_name = "hybrid_diffusion_parallel_mixer_step"


def split_last(x, sizes):
    idx, acc = [], 0
    for s in sizes[:-1]:
        acc += s
        idx.append(acc)
    return jnp.split(x, idx, axis=-1)


def rms_norm(x, g, eps=RMS_EPS):
    xf = x.astype(jnp.float32)
    y = xf * lax.rsqrt(jnp.mean(xf * xf, axis=-1, keepdims=True) + eps)
    return (y * g.astype(jnp.float32)).astype(x.dtype)


def l2_normalize(x, eps=1e-6):
    xf = x.astype(jnp.float32)
    return xf * lax.rsqrt(jnp.sum(xf * xf, axis=-1, keepdims=True) + eps)


def adaln(x, g, shift, scale):
    return rms_norm(x, g) * (1.0 + scale) + shift


def swiglu(h, w_in, w_out):
    gate, up = jnp.split(h @ w_in, 2, axis=-1)
    return (jax.nn.silu(gate) * up) @ w_out


def modulation(cond, w_mod, b_mod):
    m = jax.nn.silu(cond) @ w_mod + b_mod
    return m.reshape(cond.shape[0], N_MOD, D_MODEL)


def centred_shift(p):
    zeros = jnp.zeros_like(p[:, :1])
    prev = jnp.concatenate([zeros, p[:, :-1]], axis=1)
    nxt = jnp.concatenate([p[:, 1:], zeros], axis=1)
    return 0.5 * (prev + nxt)


def depthwise_conv(x, w):
    ch = x.shape[-1]
    pad = CONV_W // 2
    return lax.conv_general_dilated(x, w[:, None, :].astype(x.dtype), window_strides=(1,),
                                    padding=((pad, pad),), dimension_numbers=("NWC", "WIO", "NWC"),
                                    feature_group_count=ch)


def to_chunks(t):
    b, s, h = t.shape[:3]
    t = t.reshape((b, s // CHUNK, CHUNK, h) + t.shape[3:])
    return jnp.moveaxis(t, 3, 1)


def from_chunks(o):
    nc, b, h, c, d = o.shape
    return jnp.transpose(o, (1, 0, 3, 2, 4)).reshape(b, nc * c, h, d)


def rwkv7_scan(r, w, k, v, kk, a, s0):
    def step(s, inp):
        r_t, w_t, k_t, v_t, kk_t, a_t = inp
        sa = jnp.einsum("bhvk,bhk->bhv", s, -kk_t)
        s = (s * w_t[:, :, None, :] + sa[..., None] * (kk_t * a_t)[:, :, None, :]
             + v_t[..., None] * k_t[:, :, None, :])
        return s, jnp.einsum("bhvk,bhk->bhv", s, r_t)
    xs = tuple(jnp.moveaxis(t, 1, 0) for t in (r, w, k, v, kk, a))
    s_fin, ys = lax.scan(step, s0, xs)
    return jnp.moveaxis(ys, 0, 1), s_fin


def rwkv7_mixer(pa, lp, s0):
    b, s, _ = pa.shape
    pa = pa.astype(jnp.float32)
    pa = pa + lp["rwkv_mu"] * (centred_shift(pa) - pa)
    r, k, v, wd_f, wd_b, ad_f, ad_b, gd = split_last(pa, A_SIZES)
    heads = lambda t: t.reshape(b, s, A_HEADS, A_N)
    r_h, v_h = heads(r), heads(v)
    kk = l2_normalize(heads(k * lp["rwkv_k_k"]))
    g = jax.nn.sigmoid(gd) @ lp["rwkv_g_up"]
    ys, bonuses, finals = [], [], []
    for d, (wd, ad) in enumerate(((wd_f, ad_f), (wd_b, ad_b))):
        w_log = -jax.nn.softplus(-(lp["rwkv_w0"][d] + jnp.tanh(wd) @ lp["rwkv_w_up"][d])) - 0.5
        decay = heads(jnp.exp(-jnp.exp(w_log)))
        a = jax.nn.sigmoid(lp["rwkv_a0"][d] + ad @ lp["rwkv_a_up"][d])
        k_d = heads(k * (1.0 + (a - 1.0) * lp["rwkv_k_a"]))
        seqs = (r_h, decay, k_d, v_h, kk, heads(a))
        if d == 1:
            seqs = tuple(jnp.flip(t, axis=1) for t in seqs)
        y, s_fin = rwkv7_scan(*seqs, s0[:, d].astype(jnp.float32))
        ys.append(jnp.flip(y, axis=1) if d == 1 else y)
        finals.append(s_fin)
        bonuses.append(jnp.sum(r_h * k_d * lp["rwkv_r_k"], axis=-1, keepdims=True) * v_h)
    y = ys[0] + ys[1]
    mu = jnp.mean(y, axis=-1, keepdims=True)
    var = jnp.mean(jnp.square(y - mu), axis=-1, keepdims=True)
    y = ((y - mu) * lax.rsqrt(var + A_GN_EPS)).reshape(b, s, A_W) * lp["rwkv_ln_g"] + lp["rwkv_ln_b"]
    out = (y + (bonuses[0] + bonuses[1]).reshape(b, s, A_W)) * g
    return out, jnp.stack(finals, axis=1)


def gla_chunked(q, k, v, log_a, s0):
    q, k, v = to_chunks(q), to_chunks(k), to_chunks(v)
    bcum = jnp.cumsum(to_chunks(log_a), axis=-2)
    b_last = bcum[..., -1:, :]
    qg = q * jnp.exp(bcum)
    kd = k * jnp.exp(b_last - bcum)
    gl = jnp.exp(b_last[..., 0, :])
    incl = jnp.tril(jnp.ones((CHUNK, CHUNK), dtype=bool))[:, :, None]

    def step(s, inp):
        q_c, k_c, v_c, b_c, qg_c, kd_c, gl_c = inp
        rel = jnp.exp(jnp.where(incl, b_c[:, :, :, None, :] - b_c[:, :, None, :, :], -jnp.inf))
        att = jnp.einsum("bhtsd,bhtd,bhsd->bhts", rel, q_c, k_c)
        o = jnp.einsum("bhts,bhsv->bhtv", att, v_c) + jnp.einsum("bhtd,bhdv->bhtv", qg_c, s)
        s = gl_c[..., None] * s + jnp.einsum("bhsd,bhsv->bhdv", kd_c, v_c)
        return s, o
    xs = tuple(jnp.moveaxis(t, 2, 0) for t in (q, k, v, bcum, qg, kd, gl))
    s_fin, o = lax.scan(step, s0, xs)
    return from_chunks(o), s_fin


def gla_mixer(pb, lp, s0):
    b, s, _ = pb.shape
    pb = pb.astype(jnp.float32)
    q, k, v, af, ab, r = split_last(pb, B_SIZES)
    q = q.reshape(b, s, B_HEADS, B_DK) * (B_DK ** -0.5)
    k = k.reshape(b, s, B_HEADS, B_DK)
    v = v.reshape(b, s, B_HEADS, B_DV)
    outs, finals = [], []
    for d, ad in enumerate((af, ab)):
        log_a = jax.nn.log_sigmoid(ad @ lp["gla_alpha_up"][d] + lp["gla_alpha_b"][d]) / GLA_TAU
        seqs = (q, k, v, log_a.reshape(b, s, B_HEADS, B_DK))
        if d == 1:
            seqs = tuple(jnp.flip(t, axis=1) for t in seqs)
        o, s_fin = gla_chunked(*seqs, s0[:, d].astype(jnp.float32))
        outs.append(jnp.flip(o, axis=1) if d == 1 else o)
        finals.append(s_fin)
    o = rms_norm(outs[0] + outs[1], lp["gla_norm_g"]).reshape(b, s, B_V) * jax.nn.silu(r)
    return o, jnp.stack(finals, axis=1)


def delta_chunked(q, k, v, beta, g, s0):
    q, k, v = to_chunks(q), to_chunks(k), to_chunks(v)
    beta, g = to_chunks(beta), to_chunks(g)
    gc = jnp.cumsum(g, axis=-1)
    incl = jnp.tril(jnp.ones((CHUNK, CHUNK), dtype=bool))
    strict = jnp.tril(jnp.ones((CHUNK, CHUNK), dtype=bool), -1)
    decay = jnp.exp(jnp.where(incl, gc[..., :, None] - gc[..., None, :], -jnp.inf))
    kb = k * beta[..., None]
    lower = jnp.where(strict, jnp.einsum("bhntd,bhnsd->bhnts", kb, k) * decay, 0.0)
    m = lower + jnp.eye(CHUNK, dtype=lower.dtype)
    u = lax.linalg.triangular_solve(m, v * beta[..., None], left_side=True, lower=True, unit_diagonal=True)
    w = lax.linalg.triangular_solve(m, kb * jnp.exp(gc)[..., None], left_side=True, lower=True,
                                    unit_diagonal=True)
    qk = jnp.einsum("bhntd,bhnsd->bhnts", q, k) * decay
    qg = q * jnp.exp(gc)[..., None]
    kd = k * jnp.exp(gc[..., -1:] - gc)[..., None]
    gl = jnp.exp(gc[..., -1])

    def step(s, inp):
        u_c, w_c, qk_c, qg_c, kd_c, gl_c = inp
        v_new = u_c - jnp.einsum("bhtd,bhdv->bhtv", w_c, s)
        o = jnp.einsum("bhtd,bhdv->bhtv", qg_c, s) + jnp.einsum("bhts,bhsv->bhtv", qk_c, v_new)
        s = gl_c[..., None, None] * s + jnp.einsum("bhsd,bhsv->bhdv", kd_c, v_new)
        return s, o
    xs = tuple(jnp.moveaxis(t, 2, 0) for t in (u, w, qk, qg, kd, gl))
    s_fin, o = lax.scan(step, s0, xs)
    return from_chunks(o), s_fin


def delta_mixer(pc, lp, s0):
    b, s, _ = pc.shape
    pc = pc.astype(jnp.float32)
    qkv, gate, bf, bb, af, ab = split_last(pc, C_SIZES)
    qkv = jax.nn.silu(depthwise_conv(qkv, lp["delta_conv"]))
    q, k, v = split_last(qkv, (C_HEADS * C_DK, C_HEADS * C_DK, C_HEADS * C_DV))
    q = l2_normalize(q.reshape(b, s, C_HEADS, C_DK)) * (C_DK ** -0.5)
    k = l2_normalize(k.reshape(b, s, C_HEADS, C_DK))
    v = v.reshape(b, s, C_HEADS, C_DV)
    outs, finals = [], []
    for d, (bd, ad) in enumerate(((bf, af), (bb, ab))):
        beta = jax.nn.sigmoid(bd)
        g = -jnp.exp(lp["delta_a_log"][d]) * jax.nn.softplus(ad + lp["delta_dt_bias"][d])
        seqs = (q, k, v, beta, g)
        if d == 1:
            seqs = tuple(jnp.flip(t, axis=1) for t in seqs)
        o, s_fin = delta_chunked(*seqs, s0[:, d].astype(jnp.float32))
        outs.append(jnp.flip(o, axis=1) if d == 1 else o)
        finals.append(s_fin)
    o = rms_norm(outs[0] + outs[1], lp["delta_norm_g"]).reshape(b, s, C_V) * jax.nn.silu(gate)
    return o, jnp.stack(finals, axis=1)


def axial_rope_tables(n_tokens):
    rows = n_tokens // GRID_W
    t = jnp.arange(rows * GRID_W)
    row_pos = (t // GRID_W).astype(jnp.float32)
    col_pos = (t % GRID_W).astype(jnp.float32)
    half = D_HD // 2
    inv_freq = 1.0 / (ROPE_THETA ** (jnp.arange(0, half, 2, dtype=jnp.float32) / half))
    ang = jnp.stack([row_pos[:, None] * inv_freq, col_pos[:, None] * inv_freq], axis=1)
    return jnp.cos(ang), jnp.sin(ang)


def apply_axial_rope(x, cos, sin):
    b, s, h, d = x.shape
    xr = x.astype(jnp.float32).reshape(b, s, h, 2, 2, d // 4)
    x1, x2 = xr[..., 0, :], xr[..., 1, :]
    cs, sn = cos[None, :, None], sin[None, :, None]
    out = jnp.stack([x1 * cs - x2 * sn, x2 * cs + x1 * sn], axis=-2)
    return out.reshape(b, s, h, d).astype(x.dtype)


def attn_qkv(pd, lp, rope):
    b, s, _ = pd.shape
    q, k, v = split_last(pd, D_SIZES)
    q = rms_norm(q.reshape(b, s, D_HEADS, D_HD), lp["attn_q_norm"])
    k = rms_norm(k.reshape(b, s, D_KV_HEADS, D_HD), lp["attn_k_norm"])
    v = v.reshape(b, s, D_KV_HEADS, D_HD)
    if rope is not None:
        q = apply_axial_rope(q, *rope)
        k = apply_axial_rope(k, *rope)
    return q, k, v


def block_attention(q, k, v):
    b, s, hq, hd = q.shape
    kvh = k.shape[2]
    nb = s // Q_BLOCK
    qb = jnp.moveaxis(q.reshape(b, nb, Q_BLOCK, kvh, hq // kvh, hd), 1, 0)
    scale = hd ** -0.5

    def attend(q_blk):
        sc = jnp.einsum("bqngd,blnd->bngql", q_blk, k).astype(jnp.float32) * scale
        p = jax.nn.softmax(sc, axis=-1)
        return jnp.einsum("bngql,blnd->bqngd", p.astype(v.dtype), v)
    o = lax.map(attend, qb)
    return jnp.moveaxis(o, 0, 1).reshape(b, s, hq, hd)


def token_mixing(h, lp, init, ctx_kv, rope):
    b, s, _ = h.shape
    pa, pb, pc, pd, pg = split_last(h @ lp["w_in"], BLOCK_SIZES)
    y_a, st_a = rwkv7_mixer(pa, lp, init[0])
    y_b, st_b = gla_mixer(pb, lp, init[1])
    y_c, st_c = delta_mixer(pc, lp, init[2])
    q, k, v = attn_qkv(pd, lp, rope)
    if ctx_kv is None:
        keys, vals = k, v
    else:
        keys = jnp.concatenate([ctx_kv[0].astype(k.dtype), k], axis=1)
        vals = jnp.concatenate([ctx_kv[1].astype(v.dtype), v], axis=1)
    y_d = block_attention(q, keys, vals).reshape(b, s, D_HEADS * D_HD)
    branches = jnp.stack([y_a, y_b, y_c, y_d.astype(jnp.float32)], axis=2).astype(h.dtype)
    up = jnp.einsum("bsmc,mcd->bsmd", branches, lp["w_branch"])
    gates = jax.nn.sigmoid(pg.reshape(b, s, N_BRANCH, D_MODEL))
    merged = jnp.sum(gates * up, axis=2)
    return merged @ lp["w_out"], (st_a, st_b, st_c, k, v)


def trunk_layer(x, mod, lp, init, ctx_kv, rope):
    m = mod[:, None]
    h = adaln(x, lp["norm_g"][0], m[:, :, 0], m[:, :, 1])
    x = x + 0.5 * m[:, :, 2] * swiglu(h, lp["ffn_w_in"][0], lp["ffn_w_out"][0])
    h = adaln(x, lp["norm_g"][1], m[:, :, 3], m[:, :, 4])
    y, aux = token_mixing(h, lp, init, ctx_kv, rope)
    x = x + m[:, :, 5] * y
    h = adaln(x, lp["norm_g"][2], m[:, :, 6], m[:, :, 7])
    x = x + 0.5 * m[:, :, 8] * swiglu(h, lp["ffn_w_in"][1], lp["ffn_w_out"][1])
    return x, aux


def setup_inputs(seed: int = 0) -> dict:
    key = jax.random.key(seed)
    ks = iter(jax.random.split(key, 48))
    nrm = lambda shape, scale: scale * jax.random.normal(next(ks), shape, jnp.float32)
    uni = lambda shape, lo, hi: jax.random.uniform(next(ks), shape, jnp.float32, lo, hi)
    dt = jnp.exp(uni((DEPTH, 2, C_HEADS), float(np.log(1e-3)), float(np.log(1e-1))))
    return {
        "x_prompt": nrm((BATCH, SEQ, D_MODEL), 1.0),
        "x_sample": nrm((DEC_BATCH, DEC_SEQ, D_MODEL), 1.0),
        "c": nrm((DEC_BATCH, D_MODEL), 1.0),
        "cache_attn_k": nrm((DEC_BATCH, DEPTH, PAST_LEN, D_KV_HEADS, D_HD), 1.0),
        "cache_attn_v": nrm((DEC_BATCH, DEPTH, PAST_LEN, D_KV_HEADS, D_HD), 1.0),
        "state_rwkv": nrm((DEC_BATCH, DEPTH, 2, A_HEADS, A_N, A_N), 0.1),
        "state_gla": nrm((DEC_BATCH, DEPTH, 2, B_HEADS, B_DK, B_DV), 0.3),
        "state_delta": nrm((DEC_BATCH, DEPTH, 2, C_HEADS, C_DK, C_DV), 0.1),
        "c_ctx": nrm((D_MODEL,), 1.0),
        "norm_g": 1.0 + nrm((DEPTH, 3, D_MODEL), 0.02),
        "w_mod": nrm((DEPTH, D_MODEL, N_MOD * D_MODEL), 0.5 * D_MODEL ** -0.5),
        "b_mod": nrm((DEPTH, N_MOD * D_MODEL), 0.02),
        "ffn_w_in": nrm((DEPTH, 2, D_MODEL, 2 * D_FF), D_MODEL ** -0.5),
        "ffn_w_out": nrm((DEPTH, 2, D_FF, D_MODEL), D_FF ** -0.5),
        "w_in": nrm((DEPTH, D_MODEL, N_IN), D_MODEL ** -0.5),
        "rwkv_mu": uni((DEPTH, A_COLS), 0.0, 1.0),
        "rwkv_w0": uni((DEPTH, 2, A_W), -6.0, -1.0),
        "rwkv_w_up": nrm((DEPTH, 2, A_LORA_W, A_W), 0.5 * A_LORA_W ** -0.5),
        "rwkv_a0": nrm((DEPTH, 2, A_W), 0.1),
        "rwkv_a_up": nrm((DEPTH, 2, A_LORA_A, A_W), A_LORA_A ** -0.5),
        "rwkv_g_up": nrm((DEPTH, A_LORA_G, A_W), A_LORA_G ** -0.5),
        "rwkv_k_k": 0.85 + nrm((DEPTH, A_W), 0.02),
        "rwkv_k_a": 1.0 + nrm((DEPTH, A_W), 0.02),
        "rwkv_r_k": nrm((DEPTH, A_HEADS, A_N), 0.1),
        "rwkv_ln_g": 1.0 + nrm((DEPTH, A_W), 0.02),
        "rwkv_ln_b": nrm((DEPTH, A_W), 0.02),
        "gla_alpha_up": nrm((DEPTH, 2, B_LORA, B_QK), B_LORA ** -0.5),
        "gla_alpha_b": nrm((DEPTH, 2, B_QK), 0.1),
        "gla_norm_g": 1.0 + nrm((DEPTH, B_DV), 0.02),
        "delta_conv": nrm((DEPTH, CONV_W, C_QKV), CONV_W ** -0.5),
        "delta_a_log": jnp.log(uni((DEPTH, 2, C_HEADS), 1.0, 16.0)),
        "delta_dt_bias": dt + jnp.log(-jnp.expm1(-dt)),
        "delta_norm_g": 1.0 + nrm((DEPTH, C_DV), 0.02),
        "attn_q_norm": 1.0 + nrm((DEPTH, D_HD), 0.02),
        "attn_k_norm": 1.0 + nrm((DEPTH, D_HD), 0.02),
        "w_branch": nrm((DEPTH, N_BRANCH, BRANCH_W, D_MODEL), BRANCH_W ** -0.5),
        "w_out": nrm((DEPTH, D_MODEL, D_MODEL), D_MODEL ** -0.5),
        "final_norm_g": 1.0 + nrm((D_MODEL,), 0.02),
    }


def reference(x_prompt, x_sample, c, cache_attn_k, cache_attn_v, state_rwkv, state_gla, state_delta, c_ctx,
              norm_g, w_mod, b_mod, ffn_w_in, ffn_w_out, w_in, rwkv_mu, rwkv_w0, rwkv_w_up, rwkv_a0, rwkv_a_up,
              rwkv_g_up, rwkv_k_k, rwkv_k_a, rwkv_r_k, rwkv_ln_g, rwkv_ln_b, gla_alpha_up, gla_alpha_b,
              gla_norm_g, delta_conv, delta_a_log, delta_dt_bias, delta_norm_g, attn_q_norm, attn_k_norm,
              w_branch, w_out, final_norm_g):
    stacked = dict(norm_g=norm_g, w_mod=w_mod, b_mod=b_mod, ffn_w_in=ffn_w_in, ffn_w_out=ffn_w_out, w_in=w_in,
                   rwkv_mu=rwkv_mu, rwkv_w0=rwkv_w0, rwkv_w_up=rwkv_w_up, rwkv_a0=rwkv_a0, rwkv_a_up=rwkv_a_up,
                   rwkv_g_up=rwkv_g_up, rwkv_k_k=rwkv_k_k, rwkv_k_a=rwkv_k_a, rwkv_r_k=rwkv_r_k,
                   rwkv_ln_g=rwkv_ln_g, rwkv_ln_b=rwkv_ln_b, gla_alpha_up=gla_alpha_up, gla_alpha_b=gla_alpha_b,
                   gla_norm_g=gla_norm_g, delta_conv=delta_conv, delta_a_log=delta_a_log,
                   delta_dt_bias=delta_dt_bias, delta_norm_g=delta_norm_g, attn_q_norm=attn_q_norm,
                   attn_k_norm=attn_k_norm, w_branch=w_branch, w_out=w_out)
    layers = [{name: arr[l] for name, arr in stacked.items()} for l in range(DEPTH)]

    bp = x_prompt.shape[0]
    zero_init = (jnp.zeros((bp, 2, A_HEADS, A_N, A_N), jnp.float32),
                 jnp.zeros((bp, 2, B_HEADS, B_DK, B_DV), jnp.float32),
                 jnp.zeros((bp, 2, C_HEADS, C_DK, C_DV), jnp.float32))
    x = x_prompt
    ks, vs, srs, sgs, sds = [], [], [], [], []
    for l in range(DEPTH):
        lp = layers[l]
        mod = modulation(c_ctx[None, :], lp["w_mod"], lp["b_mod"])
        x, (s_r, s_g, s_d, k, v) = trunk_layer(x, mod, lp, zero_init, None, None)
        ks.append(k)
        vs.append(v)
        srs.append(s_r)
        sgs.append(s_g)
        sds.append(s_d)
    y_prompt = rms_norm(x, final_norm_g)
    new_cache_attn_k = jnp.stack(ks, axis=1)
    new_cache_attn_v = jnp.stack(vs, axis=1)
    new_state_rwkv = jnp.stack(srs, axis=1)
    new_state_gla = jnp.stack(sgs, axis=1)
    new_state_delta = jnp.stack(sds, axis=1)

    rope = axial_rope_tables(x_sample.shape[1])
    x = x_sample
    for l in range(DEPTH):
        lp = layers[l]
        mod = modulation(c, lp["w_mod"], lp["b_mod"])
        init = (state_rwkv[:, l], state_gla[:, l], state_delta[:, l])
        x, _ = trunk_layer(x, mod, lp, init, (cache_attn_k[:, l], cache_attn_v[:, l]), rope)
    y_sample = rms_norm(x, final_norm_g)

    return (y_prompt, y_sample, new_cache_attn_k, new_cache_attn_v, new_state_rwkv, new_state_gla, new_state_delta)
```

```cpp
#include <hip/hip_runtime.h>
#include <hip/hip_cooperative_groups.h>
#include <cstdio>
#include <cstdint>
namespace cg = cooperative_groups;

#define LAS __attribute__((address_space(3)))
typedef unsigned short bf16;
typedef short bf16x8 __attribute__((ext_vector_type(8)));
typedef short s16x4 __attribute__((ext_vector_type(4)));
typedef float f32x4 __attribute__((ext_vector_type(4)));
typedef float f32x2 __attribute__((ext_vector_type(2)));
typedef float f32x16 __attribute__((ext_vector_type(16)));
typedef unsigned u32x4 __attribute__((ext_vector_type(4)));
typedef unsigned u32x2 __attribute__((ext_vector_type(2)));

constexpr int M = 12288, MC = 4096, D = 1024, FF = 2816, NP = 7680, NIN = 7632;
constexpr int PA = 0, PB = 1184, PC = 1984, PD = 3024, PG = 3536;
constexpr int NFEAT = 1280;
enum { I_XP = 0, I_XS, I_C, I_CK, I_CV, I_SR, I_SG, I_SD, I_CCTX, I_NG, I_WMOD, I_BMOD, I_FW1, I_FW2, I_WIN, I_MU, I_W0, I_WUP, I_A0, I_AUP, I_GUP,
       I_KK, I_KA, I_RK, I_LNG, I_LNB, I_GAU, I_GAB, I_GNG, I_DCV, I_DAL, I_DDT, I_DNG, I_QN, I_KN, I_WBR, I_WOUT, I_FNG, N_INPUTS };
constexpr size_t O_Y = 0, O_CK = 12582912, O_CV = 13631488, O_SR = 14680064, O_SG = 15728640, O_SD = 16252928, O_END = 17301504;
constexpr size_t MiB = 1u << 20;
constexpr size_t WS_CTL = 0, CTL_BYTES = 1 * MiB;
constexpr size_t WS_MOD = 1 * MiB;
constexpr size_t WS_W1 = 2 * MiB;
constexpr size_t WS_W2 = 13 * MiB;
constexpr size_t WS_WIN = 19 * MiB;
constexpr size_t WS_WB = 34 * MiB;
constexpr size_t WS_WO = 36 * MiB;
constexpr size_t WS_WL = 38 * MiB;
constexpr size_t WS_XN = 40 * MiB;
constexpr size_t WS_Y = 64 * MiB;
constexpr size_t WS_P = 88 * MiB;
constexpr size_t WS_FEAT = 268 * MiB;
constexpr size_t WS_YP = 298 * MiB;
constexpr size_t WS_QN = 334 * MiB;
constexpr size_t WS_KN = 340 * MiB;
constexpr size_t WS_VT = 344 * MiB;
constexpr size_t WS_MG = 268 * MiB;
constexpr size_t WS_XB = 348 * MiB;
constexpr size_t WS_END = 349 * MiB;
constexpr int CW_Q = 1024;
constexpr int LDS_BYTES = 147456, MISC_OFF = 143360;
constexpr int NPH = 21;
constexpr int CW_HDONE = 65536;
constexpr int CW_HLATE = 131072;
constexpr int CW_SEAM = 16384;

__device__ __forceinline__ float bf2f(bf16 v) { return __uint_as_float(((unsigned)v) << 16); }
__device__ __forceinline__ unsigned f2bf(float f) { unsigned u = __float_as_uint(f); return (u + 0x7fffu + ((u >> 16) & 1u)) >> 16; }
typedef __bf16 bf16x2_t __attribute__((ext_vector_type(2)));
__device__ __forceinline__ unsigned pk2(float lo, float hi) { f32x2 v = {lo, hi}; bf16x2_t b = __builtin_convertvector(v, bf16x2_t); return __builtin_bit_cast(unsigned, b); }
__device__ __forceinline__ unsigned cvtpk(float lo, float hi) { f32x2 v = {lo, hi}; bf16x2_t b = __builtin_convertvector(v, bf16x2_t); return __builtin_bit_cast(unsigned, b); }
#define DPPF(v, ctrl) __int_as_float(__builtin_amdgcn_update_dpp(0, __float_as_int(v), (ctrl), 0xF, 0xF, true))
__device__ __forceinline__ float row16_sum(float v) { v += DPPF(v, 0xB1); v += DPPF(v, 0x4E); v += DPPF(v, 0x141); v += DPPF(v, 0x140); return v; }
__device__ __forceinline__ float swz_xor16(float v) { return __int_as_float(__builtin_amdgcn_ds_swizzle(__float_as_int(v), 0x401F)); }
__device__ __forceinline__ float wave_sum(float v) {
    v = row16_sum(v); v += swz_xor16(v);
    return __int_as_float(__builtin_amdgcn_readlane(__float_as_int(v), 0)) + __int_as_float(__builtin_amdgcn_readlane(__float_as_int(v), 32));
}
__device__ __forceinline__ float xor32(float v, int lane) { return __int_as_float(__builtin_amdgcn_ds_bpermute((lane ^ 32) << 2, __float_as_int(v))); }
__device__ __forceinline__ float sigm(float x) { return __builtin_amdgcn_rcpf(1.f + __expf(-x)); }
__device__ __forceinline__ float siluf(float x) { return x * __builtin_amdgcn_rcpf(1.f + __expf(-x)); }
__device__ __forceinline__ float softplusf(float x) { return fmaxf(x, 0.f) + __logf(1.f + __expf(-fabsf(x))); }
__device__ __forceinline__ float tanhf_(float x) { return 1.f - 2.f * __builtin_amdgcn_rcpf(1.f + __expf(2.f * x)); }
__device__ __forceinline__ float dpp_x1(float v) { return __int_as_float(__builtin_amdgcn_update_dpp(0, __float_as_int(v), 0xB1, 0xF, 0xF, true)); }
__device__ __forceinline__ float dpp_x2(float v) { return __int_as_float(__builtin_amdgcn_update_dpp(0, __float_as_int(v), 0x4E, 0xF, 0xF, true)); }
__device__ __forceinline__ float quad_sum(float v) { v += dpp_x1(v); v += dpp_x2(v); return v; }
__device__ __forceinline__ f32x4 ld_bf4(const bf16* p) { const u32x2 w = *(const u32x2*)p; f32x4 r; r.x = __uint_as_float(w.x << 16); r.y = __uint_as_float(w.x & 0xffff0000u); r.z = __uint_as_float(w.y << 16); r.w = __uint_as_float(w.y & 0xffff0000u); return r; }
__device__ __forceinline__ void st_bf4(bf16* p, f32x4 v) { u32x2 w; w.x = pk2(v.x, v.y); w.y = pk2(v.z, v.w); *(u32x2*)p = w; }
__device__ __forceinline__ f32x4 unbf4_(u32x2 w) { f32x4 r; r.x = __uint_as_float(w.x << 16); r.y = __uint_as_float(w.x & 0xffff0000u); r.z = __uint_as_float(w.y << 16); r.w = __uint_as_float(w.y & 0xffff0000u); return r; }
#define LDS_WAIT() asm volatile("s_waitcnt lgkmcnt(0)" ::: "memory")

namespace pg8 {
#define PG8_LAS __attribute__((address_space(3)))
constexpr int BM = 256, BK = 64, HALF = 128, HTB = HALF * BK * 2, STAGE_BYTES = 8 * HTB, NXCD = 8, WGM = 8;
__host__ __device__ __forceinline__ int lds_byte(int r, int c) { const int st = (r >> 4) * 2 + (c >> 5), rr = r & 15, cc = c & 31, ob = rr * 64 + cc * 2; return st * 1024 + (ob ^ (((ob >> 9) & 1) << 5)); }
__host__ __device__ __forceinline__ void stage_rc(int b, int& R, int& C) { const int st = b / 1024, sb = b % 1024, swz = sb ^ (((sb >> 9) & 1) << 5); R = (st >> 1) * 16 + swz / 64; C = (st & 1) * 32 + (swz % 64) / 2; }
__host__ __device__ __forceinline__ int perm32(int rho) { const int n = rho >> 4, i = rho & 15; return 8 * (i >> 2) + 4 * n + (i & 3); }
struct Unit { int pm, pn, late; };
struct Gemm { const bf16* A; const bf16* Bt; int M, N, K, lda, ldb; };
struct StaticOrder {
    int nM, nN, nwg, G, c;
    __device__ void init(int M_, int N_, int G_, int c_) { nM = M_ / BM; nN = N_ / BM; nwg = nM * nN; G = G_; c = c_; }
    __device__ bool next(int i, Unit& u) const {
        const long L = (long)i * G + c; if (L >= nwg) return false;
        int wgid = (int)L; { const int q = nwg / NXCD, r = nwg % NXCD, xcd = wgid % NXCD, off = wgid / NXCD; wgid = (xcd < r ? xcd * (q + 1) : r * (q + 1) + (xcd - r) * q) + off; }
        const int nig = WGM * nN, gid = wgid / nig, fm = gid * WGM, gsz = (nM - fm) < WGM ? (nM - fm) : WGM;
        u.pm = fm + ((wgid % nig) % gsz); u.pn = (wgid % nig) / gsz; u.late = (L >= (long)(nwg / G) * G) ? 1 : 0; return true;
    }
};
__device__ __forceinline__ unsigned cvt_pk_bf16(float lo, float hi) { unsigned r; asm volatile("v_cvt_pk_bf16_f32 %0, %1, %2" : "=v"(r) : "v"(lo), "v"(hi)); return r; }

struct EpiSwiglu {
    static constexpr bool PERM = true, AFTER_DRAIN = false, KPERM = false, ALIGN_EPI = false;
    bf16* H; unsigned* done_cnt; unsigned* late_cnt;
    __device__ __forceinline__ void operator()(const f32x4 (&acc)[2][2][4][2], const Unit& u, int wr, int wc, int fr, int fq) const {
        const int row0 = u.pm * BM + wr * 64 + fr, col0 = u.pn * 128 + wc * 32 + 8 * fq;
        const __amdgpu_buffer_rsrc_t rsrc = __builtin_amdgcn_make_buffer_rsrc((void*)H, 0, M * FF * 2, 0x00020000);
#pragma unroll
        for (int ai = 0; ai < 2; ++ai)
#pragma unroll
            for (int m = 0; m < 4; ++m) {
                const unsigned off = (unsigned)((row0 + ai * HALF + m * 16) * FF + col0) * 2u;
                const f32x4 g0 = acc[ai][0][m][0], g1 = acc[ai][0][m][1], u0 = acc[ai][1][m][0], u1 = acc[ai][1][m][1];
                u32x4 w;
                w.x = cvt_pk_bf16(siluf(g0[0]) * u0[0], siluf(g0[1]) * u0[1]); w.y = cvt_pk_bf16(siluf(g0[2]) * u0[2], siluf(g0[3]) * u0[3]);
                w.z = cvt_pk_bf16(siluf(g1[0]) * u1[0], siluf(g1[1]) * u1[1]); w.w = cvt_pk_bf16(siluf(g1[2]) * u1[2], siluf(g1[3]) * u1[3]);
                __builtin_amdgcn_raw_buffer_store_b128(w, rsrc, off, 0,   16);
            }
    }
    __device__ __forceinline__ void publish(const Unit& u, int lane) const { if (lane == 0) __hip_atomic_fetch_add((u.late ? late_cnt : done_cnt) + 64 * u.pm, 1u, __ATOMIC_RELAXED, __HIP_MEMORY_SCOPE_AGENT); }
    __device__ __forceinline__ void a_ready(const Unit&, int, int) const {}
};
struct EpiRes {
    static constexpr bool PERM = false, AFTER_DRAIN = false, KPERM = false, ALIGN_EPI = true;
    const float* base0; const float* base1; float* out; const float* modl; int gi; float coef;
    __device__ __forceinline__ void publish(const Unit&, int) const {}
    __device__ __forceinline__ void a_ready(const Unit&, int, int) const {}
    __device__ __forceinline__ void operator()(const f32x4 (&acc)[2][2][4][2], const Unit& u, int wr, int wc, int fr, int fq) const {
        const int cond = u.pm < 16 ? 0 : 1 + ((u.pm - 16) >> 2);
        const int row0 = u.pm * BM + wr * 64 + fr, col0 = u.pn * BM + wc * 32 + 4 * fq;
        const float* gv = modl + cond * 9216 + gi * 1024 + col0;
        f32x4 gvv[2][2];
#pragma unroll
        for (int bj = 0; bj < 2; ++bj)
#pragma unroll
            for (int n = 0; n < 2; ++n) gvv[bj][n] = *(const f32x4*)(gv + bj * HALF + n * 16) * coef;
#pragma unroll
        for (int ai = 0; ai < 2; ++ai)
#pragma unroll
            for (int m = 0; m < 4; ++m) {
                const int row = row0 + ai * HALF + m * 16;
                const float* bp = (row < MC ? base0 + (size_t)row * D : base1 + (size_t)(row - MC) * D) + col0;
                float* op = out + (size_t)row * D + col0;
#pragma unroll
                for (int bj = 0; bj < 2; ++bj)
#pragma unroll
                    for (int n = 0; n < 2; ++n) *(f32x4*)(op + bj * HALF + n * 16) = *(const f32x4*)(bp + bj * HALF + n * 16) + gvv[bj][n] * acc[ai][bj][m][n];
            }
    }
};
struct EpiResNorm {
    static constexpr bool PERM = true, AFTER_DRAIN = true, KPERM = true, ALIGN_EPI = true;
    const float* base0; const float* base1; float* out; const float* modl; int gi; float coef;
    const float* ng; const float* nmod; int ni; bf16* xn; float* xbuf; unsigned* cnt; bool final_;
    unsigned* xnd;
    const unsigned* ready; unsigned need;
    const unsigned* lready; int gridG;
    __device__ __forceinline__ int late_pn(const Unit& u) const {
        if (lready == nullptr) return -1;
        StaticOrder S; S.init(M, 2 * FF, gridG, 0); int r = -1;
        for (int L = (S.nwg / gridG) * gridG; L < S.nwg; ++L) { Unit v; S.c = L % gridG; S.next(L / gridG, v); if (v.pm == u.pm) r = v.pn; }
        return r;
    }
    __device__ __forceinline__ void late_wait(const Unit& u, int wid) const {
        int w_ = wid; asm volatile("" : "+s"(w_));
        if (w_ == 0) {
            unsigned spins = 0;
            while ((unsigned)__builtin_amdgcn_readfirstlane(__hip_atomic_load(lready + 64 * u.pm, __ATOMIC_RELAXED, __HIP_MEMORY_SCOPE_AGENT)) < 8u) { __builtin_amdgcn_s_sleep(2); if (++spins > (1u << 22)) break; }
            __builtin_amdgcn_fence(__ATOMIC_ACQUIRE, "agent");
            asm volatile("s_waitcnt vmcnt(0)" ::: "memory");
        }
        asm volatile("" ::: "memory"); __builtin_amdgcn_s_barrier(); asm volatile("" ::: "memory");
    }
    __device__ __forceinline__ void publish(const Unit&, int) const {}
    __device__ __forceinline__ void a_ready(const Unit& u, int wid, int lane) const {
        if (ready == nullptr) return;
        if (wid == 0) {
            unsigned spins = 0;
            const unsigned need_ = (late_pn(u) >= 0) ? need - 8u : need;
            while ((unsigned)__builtin_amdgcn_readfirstlane(__hip_atomic_load(ready + 64 * u.pm, __ATOMIC_RELAXED, __HIP_MEMORY_SCOPE_AGENT)) < need_) { __builtin_amdgcn_s_sleep(2); if (++spins > (1u << 22)) break; }
            __builtin_amdgcn_fence(__ATOMIC_ACQUIRE, "agent");
            asm volatile("s_waitcnt vmcnt(0)" ::: "memory");
        }
        asm volatile("" ::: "memory"); __builtin_amdgcn_s_barrier(); asm volatile("" ::: "memory");
    }
    __device__ __forceinline__ void fused(f32x4 (&acc)[2][2][4][2], const Unit& u, int wr, int wc, int fr, int fq, PG8_LAS unsigned char* lds, int wid, int lane) const {
        PG8_LAS float* P = (PG8_LAS float*)lds;
        PG8_LAS float* S = (PG8_LAS float*)(lds + 4096);
        const int cond = u.pm < 16 ? 0 : 1 + ((u.pm - 16) >> 2);
        const int row0 = u.pm * BM + wr * 64 + fr, col0 = u.pn * BM + wc * 32 + 8 * fq;
        {
            const float* gv = modl + cond * 9216 + gi * 1024 + col0;
            f32x4 gvv[2][2];
#pragma unroll
            for (int bj = 0; bj < 2; ++bj)
#pragma unroll
                for (int n = 0; n < 2; ++n) gvv[bj][n] = *(const f32x4*)(gv + bj * HALF + n * 4) * coef;
#pragma unroll
            for (int ai = 0; ai < 2; ++ai)
#pragma unroll
                for (int m = 0; m < 4; ++m) {
                    const int row = row0 + ai * HALF + m * 16;
                    const float* bp = (row < MC ? base0 + (size_t)row * D : base1 + (size_t)(row - MC) * D) + col0;
                    float* op = out + (size_t)row * D + col0;
                    float s = 0.f;
#pragma unroll
                    for (int bj = 0; bj < 2; ++bj)
#pragma unroll
                        for (int n = 0; n < 2; ++n) { const f32x4 x = *(const f32x4*)(bp + bj * HALF + n * 4) + gvv[bj][n] * acc[ai][bj][m][n]; acc[ai][bj][m][n] = x;
                            if (!final_) *(f32x4*)(op + bj * HALF + n * 4) = x;
                            s += (x[0] * x[0] + x[1] * x[1]) + (x[2] * x[2] + x[3] * x[3]); }
                    s += swz_xor16(s); s += xor32(s, lane);
                    if (fq == 0) P[(ai * HALF + wr * 64 + m * 16 + fr) * 4 + wc] = s;
                    if (m & 1) asm volatile("" ::: "memory");
                }
        }
        asm volatile("s_waitcnt lgkmcnt(0)" ::: "memory"); __builtin_amdgcn_s_barrier(); asm volatile("" ::: "memory");
        const int row = wid * 32 + (lane & 31);
        if (lane < 32) {
            const f32x4 p4 = *(const PG8_LAS f32x4*)(P + row * 4);
            __hip_atomic_store(xbuf + ((size_t)(u.pm * BM + row) * 4 + u.pn), (p4[0] + p4[1]) + (p4[2] + p4[3]), __ATOMIC_RELAXED, __HIP_MEMORY_SCOPE_AGENT);
        }
        asm volatile("s_waitcnt vmcnt(0)" ::: "memory");
        if (lane == 0) __hip_atomic_fetch_add(cnt + 64 * u.pm, 1u, __ATOMIC_RELAXED, __HIP_MEMORY_SCOPE_AGENT);
        if (wid == 0) {
            unsigned spins = 0;
            while ((unsigned)__builtin_amdgcn_readfirstlane(__hip_atomic_load(cnt + 64 * u.pm, __ATOMIC_RELAXED, __HIP_MEMORY_SCOPE_AGENT)) < 32u) { __builtin_amdgcn_s_sleep(2); if (++spins > (1u << 22)) break; }
            __builtin_amdgcn_fence(__ATOMIC_ACQUIRE, "agent");
        }
        asm volatile("s_waitcnt vmcnt(0) lgkmcnt(0)" ::: "memory"); __builtin_amdgcn_s_barrier(); asm volatile("" ::: "memory");
        if (lane < 32) {
            const float* slot = xbuf + (size_t)(u.pm * BM + row) * 4; float t = 0.f;
#pragma unroll
            for (int q = 0; q < 4; ++q) t += __hip_atomic_load(slot + q, __ATOMIC_RELAXED, __HIP_MEMORY_SCOPE_AGENT);
            S[row] = rsqrtf(t * (1.f / 1024.f) + 1e-6f);
        }
        asm volatile("s_waitcnt vmcnt(0) lgkmcnt(0)" ::: "memory"); __builtin_amdgcn_s_barrier(); asm volatile("" ::: "memory");
        f32x4 g4[2][2], sc4[2][2], sh4[2][2];
        const __amdgpu_buffer_rsrc_t xrs = __builtin_amdgcn_make_buffer_rsrc((void*)xn, 0, M * D * 2, 0x00020000);
#pragma unroll
        for (int bj = 0; bj < 2; ++bj)
#pragma unroll
            for (int n = 0; n < 2; ++n) {
                const int c = col0 + bj * HALF + n * 4;
                g4[bj][n] = *(const f32x4*)(ng + c);
                if (!final_) { const float* mp = nmod + (size_t)cond * 9216 + (3 * ni) * 1024 + c; sh4[bj][n] = *(const f32x4*)mp; sc4[bj][n] = *(const f32x4*)(mp + 1024) + 1.f; g4[bj][n] = g4[bj][n] * sc4[bj][n]; }
            }
#pragma unroll
        for (int ai = 0; ai < 2; ++ai)
#pragma unroll
            for (int m = 0; m < 4; ++m) {
                const int r = ai * HALF + wr * 64 + m * 16 + fr; const float rs = S[r]; const size_t off = (size_t)(u.pm * BM + r) * D + col0;
#pragma unroll
                for (int bj = 0; bj < 2; ++bj) {
                    const f32x4 y0 = acc[ai][bj][m][0] * rs * g4[bj][0], y1 = acc[ai][bj][m][1] * rs * g4[bj][1];
                    if (final_) { *(f32x4*)(out + off + bj * HALF) = y0; *(f32x4*)(out + off + bj * HALF + 4) = y1; }
                    else { const f32x4 z0 = y0 + sh4[bj][0], z1 = y1 + sh4[bj][1]; u32x4 w; w.x = cvt_pk_bf16(z0[0], z0[1]); w.y = cvt_pk_bf16(z0[2], z0[3]); w.z = cvt_pk_bf16(z1[0], z1[1]); w.w = cvt_pk_bf16(z1[2], z1[3]);
                        __builtin_amdgcn_raw_buffer_store_b128(w, xrs, (unsigned)(off + bj * HALF) * 2u, 0,   16); }
                }
            }
        if (xnd != nullptr) { asm volatile("s_waitcnt vmcnt(0)" ::: "memory"); if (lane == 0) __hip_atomic_fetch_add(xnd + 64 * u.pm, 1u, __ATOMIC_RELAXED, __HIP_MEMORY_SCOPE_AGENT); }
    }
};
struct EpiP {
    static constexpr bool PERM = true, AFTER_DRAIN = false, KPERM = false, ALIGN_EPI = true;
    bf16* O; int ldc;
    __device__ __forceinline__ void publish(const Unit&, int) const {}
    __device__ __forceinline__ void a_ready(const Unit&, int, int) const {}
    __device__ __forceinline__ void operator()(const f32x4 (&acc)[2][2][4][2], const Unit& u, int wr, int wc, int fr, int fq) const {
        const int row0 = u.pm * BM + wr * 64 + fr, col0 = u.pn * BM + wc * 32 + 8 * fq;
#pragma unroll
        for (int ai = 0; ai < 2; ++ai)
#pragma unroll
            for (int m = 0; m < 4; ++m) {
                bf16* rowp = O + (size_t)(row0 + ai * HALF + m * 16) * ldc + col0;
#pragma unroll
                for (int bj = 0; bj < 2; ++bj) {
                    const f32x4 v0 = acc[ai][bj][m][0], v1 = acc[ai][bj][m][1];
                    u32x4 w; w.x = cvt_pk_bf16(v0[0], v0[1]); w.y = cvt_pk_bf16(v0[2], v0[3]); w.z = cvt_pk_bf16(v1[0], v1[1]); w.w = cvt_pk_bf16(v1[2], v1[3]);
                    *(u32x4*)(rowp + bj * HALF) = w;
                }
            }
    }
};
struct EpiFeat {
    static constexpr bool PERM = true, AFTER_DRAIN = false, KPERM = false, ALIGN_EPI = true;
    bf16* O; const float* w0; const float* a0;
    __device__ __forceinline__ void publish(const Unit&, int) const {}
    __device__ __forceinline__ void a_ready(const Unit&, int, int) const {}
    __device__ __forceinline__ void operator()(const f32x4 (&acc)[2][2][4][2], const Unit& u, int wr, int wc, int fr, int fq) const {
        const int row0 = u.pm * BM + wr * 64 + fr, cl = wc * 32 + 8 * fq, kind = u.pn;
        const float* bsrc = (kind < 2) ? w0 + kind * 256 : a0 + ((kind - 2) & 1) * 256;
        f32x4 bv[2][2];
#pragma unroll
        for (int bj = 0; bj < 2; ++bj)
#pragma unroll
            for (int n = 0; n < 2; ++n) bv[bj][n] = (kind < 4) ? *(const f32x4*)(bsrc + cl + bj * HALF + 4 * n) : (f32x4){0.f, 0.f, 0.f, 0.f};
        const float sc = (kind < 2) ? 0.6065306597f : 1.f;
#pragma unroll
        for (int ai = 0; ai < 2; ++ai)
#pragma unroll
            for (int m = 0; m < 4; ++m) {
                bf16* rowp = O + (size_t)(row0 + ai * HALF + m * 16) * NFEAT + kind * 256 + cl;
#pragma unroll
                for (int bj = 0; bj < 2; ++bj) {
                    f32x4 v0 = acc[ai][bj][m][0] + bv[bj][0], v1 = acc[ai][bj][m][1] + bv[bj][1];
                    if (kind < 4) { v0 = (f32x4){sigm(v0[0]), sigm(v0[1]), sigm(v0[2]), sigm(v0[3])} * sc; v1 = (f32x4){sigm(v1[0]), sigm(v1[1]), sigm(v1[2]), sigm(v1[3])} * sc; }
                    u32x4 w; w.x = cvt_pk_bf16(v0[0], v0[1]); w.y = cvt_pk_bf16(v0[2], v0[3]); w.z = cvt_pk_bf16(v1[0], v1[1]); w.w = cvt_pk_bf16(v1[2], v1[3]);
                    *(u32x4*)(rowp + bj * HALF) = w;
                }
            }
    }
};
struct EpiBranch {
    static constexpr bool PERM = false, AFTER_DRAIN = false, KPERM = false, ALIGN_EPI = true;
    int m; const bf16* G; float* MG; bf16* OUT;
    __device__ __forceinline__ void publish(const Unit&, int) const {}
    __device__ __forceinline__ void a_ready(const Unit&, int, int) const {}
    __device__ __forceinline__ void operator()(const f32x4 (&acc)[2][2][4][2], const Unit& u, int wr, int wc, int fr, int fq) const {
        const int row0 = u.pm * BM + wr * 64 + fr, col0 = u.pn * BM + wc * 32 + 4 * fq;
#pragma unroll
        for (int ai = 0; ai < 2; ++ai)
#pragma unroll
            for (int mm = 0; mm < 4; ++mm) {
                const int row = row0 + ai * HALF + mm * 16;
#pragma unroll
                for (int bj = 0; bj < 2; ++bj)
#pragma unroll
                    for (int n = 0; n < 2; ++n) {
                        const int col = col0 + bj * HALF + n * 16;
                        const f32x4 g = ld_bf4(G + (size_t)row * NP + col);
                        const f32x4 a = acc[ai][bj][mm][n];
                        f32x4 v; v.x = sigm(g.x) * a.x; v.y = sigm(g.y) * a.y; v.z = sigm(g.z) * a.z; v.w = sigm(g.w) * a.w;
                        float* mp = MG + (size_t)row * D + col;
                        if (m > 0) v += *(const f32x4*)mp;
                        if (m < 3) *(f32x4*)mp = v; else st_bf4(OUT + (size_t)row * D + col, v);
                    }
                asm volatile("" ::: "memory");
            }
    }
};

template <class Epi>
__device__ __forceinline__ void gemm_phase(PG8_LAS unsigned char* lds, const int tid, const Gemm g, const StaticOrder& S, const Epi& E) {
    const int wid = __builtin_amdgcn_readfirstlane(tid >> 6), lane = tid & 63, wr = wid >> 2, wc = wid & 3, fr = lane & 15, fq = lane >> 4;
    const int K = g.K, nt = K / BK;
    unsigned voffA[2], voffB[2];
#pragma unroll
    for (int i = 0; i < 2; ++i) { int R, C; stage_rc(tid * 16 + i * 8192, R, C); const int Rb = Epi::PERM ? ((R & ~31) + perm32(R & 31)) : R;
        voffA[i] = (unsigned)(R * g.lda + C) * 2u; voffB[i] = (unsigned)(Rb * g.ldb + C) * 2u; }
    const size_t kstep = (size_t)(BK * 2);
    const size_t hstepA = (size_t)HALF * g.lda * 2, hstepB = (size_t)HALF * g.ldb * 2;
    const size_t tstepA = 2 * hstepA, tstepB = 2 * hstepB;
    const unsigned ldsw = (unsigned)wid * 1024u;
    const int aoff = lds_byte(wr * 64 + fr, fq * 8), boff = lds_byte(wc * 32 + fr, fq * 8);
#define PG8_SA(b, h) (((b) * 2 + (h)) * HTB)
#define PG8_SB(b, h) ((4 + (b) * 2 + (h)) * HTB)
#define PG8_STAGE(bufoff, gbase, voff) do { _Pragma("unroll") for (int _i = 0; _i < 2; ++_i) \
        __builtin_amdgcn_global_load_lds((const unsigned*)((const char*)(gbase) + (voff)[_i]), (PG8_LAS unsigned*)(lds + (bufoff) + ldsw + _i * 8192), 16, 0, 0); } while (0)
#define PG8_LDA(dst, b, h) do { _Pragma("unroll") for (int m = 0; m < 4; ++m) _Pragma("unroll") for (int k = 0; k < 2; ++k) dst[m][k] = *(const PG8_LAS bf16x8*)(lds + PG8_SA(b, h) + aoff + m * 2048 + k * 1024); } while (0)
#define PG8_LDB(dst, b, h) do { _Pragma("unroll") for (int n = 0; n < 2; ++n) _Pragma("unroll") for (int k = 0; k < 2; ++k) dst[n][k] = *(const PG8_LAS bf16x8*)(lds + PG8_SB(b, h) + boff + n * 2048 + k * 1024); } while (0)
#define PG8_MMA(ai, bj, At, Bt) do { __builtin_amdgcn_s_setprio(1); _Pragma("unroll") for (int m = 0; m < 4; ++m) _Pragma("unroll") for (int n = 0; n < 2; ++n) _Pragma("unroll") for (int k = 0; k < 2; ++k) \
        acc[ai][bj][m][n] = __builtin_amdgcn_mfma_f32_16x16x32_bf16(Bt[n][k], At[m][k], acc[ai][bj][m][n], 0, 0, 0); __builtin_amdgcn_s_setprio(0); } while (0)
#define PG8_WAIT_V(n) asm volatile("s_waitcnt vmcnt(" #n ")" ::: "memory")
#define PG8_WAIT_L(n) asm volatile("s_waitcnt lgkmcnt(" #n ")" ::: "memory")
#define PG8_BAR __builtin_amdgcn_s_barrier()
#define PG8_SCHED __builtin_amdgcn_sched_barrier(0)
    Unit cur, nxt; int ui = 0;
    if (!S.next(0, cur)) return;
    int pl2 = nt - 2; bool haslate = false;
    if constexpr (Epi::KPERM) { const int lp = E.late_pn(cur); if (lp >= 0) { pl2 = 2 * lp; haslate = true; } }
    auto koff = [&](int tile) -> size_t { if constexpr (!Epi::KPERM) return (size_t)tile * kstep; else return (size_t)(tile < pl2 ? tile : (tile < nt - 2 ? tile + 2 : tile - (nt - 2) + pl2)) * kstep; };
    f32x4 acc[2][2][4][2];
#pragma unroll
    for (int a = 0; a < 2; ++a)
#pragma unroll
        for (int b = 0; b < 2; ++b)
#pragma unroll
            for (int m = 0; m < 4; ++m)
#pragma unroll
                for (int n = 0; n < 2; ++n) acc[a][b][m][n] = (f32x4){0.f, 0.f, 0.f, 0.f};
    bf16x8 At[4][2], B0[2][2], B1[2][2];
    const char* cA = (const char*)g.A + (size_t)cur.pm * tstepA; const char* cB = (const char*)g.Bt + (size_t)cur.pn * tstepB;
    E.a_ready(cur, wid, lane);
    Unit prev = cur;
    { const size_t k0_ = koff(0);
    PG8_STAGE(PG8_SB(0, 0), cB + k0_, voffB); PG8_STAGE(PG8_SB(0, 1), cB + k0_ + hstepB, voffB); PG8_STAGE(PG8_SA(0, 0), cA + k0_, voffA); PG8_STAGE(PG8_SA(0, 1), cA + k0_ + hstepA, voffA);
    if (wr == 1) PG8_BAR;
    PG8_WAIT_V(2); PG8_BAR;
    PG8_STAGE(PG8_SB(1, 0), cB + k0_ + kstep, voffB); PG8_STAGE(PG8_SA(1, 0), cA + k0_ + kstep, voffA); PG8_STAGE(PG8_SB(1, 1), cB + k0_ + hstepB + kstep, voffB); }
    PG8_WAIT_V(6); PG8_BAR;
    for (;;) {
        const bool has_next = S.next(ui + 1, nxt);
        const char* nA = has_next ? (const char*)g.A + (size_t)nxt.pm * tstepA : cA; const char* nB = has_next ? (const char*)g.Bt + (size_t)nxt.pn * tstepB : cB;
        for (int t = 0; t < nt; t += 2) {
            const bool last = (t == nt - 2);
            if constexpr (Epi::KPERM) { if (haslate && t == nt - 4) E.late_wait(cur, wid); }
            const char* a1 = cA + koff(t) + kstep;
            const char* a2 = last ? nA : cA + koff(t + 2); const char* b2 = last ? nB : cB + koff(t + 2);
            const char* a3 = a2 + kstep; const char* b3 = b2 + kstep;
            PG8_LDB(B0, 0, 0); PG8_LDB(B1, 0, 1); PG8_SCHED; PG8_LDA(At, 0, 0); PG8_STAGE(PG8_SA(1, 1), a1 + hstepA, voffA);
            PG8_WAIT_V(8); PG8_WAIT_L(0); PG8_BAR; PG8_MMA(0, 0, At, B0); PG8_MMA(0, 1, At, B1); PG8_BAR; PG8_SCHED;
            PG8_LDA(At, 0, 1); PG8_STAGE(PG8_SB(0, 0), b2, voffB); PG8_STAGE(PG8_SB(0, 1), b2 + hstepB, voffB); PG8_STAGE(PG8_SA(0, 0), a2, voffA);
            PG8_WAIT_V(8); PG8_WAIT_L(0); PG8_BAR; PG8_MMA(1, 0, At, B0); PG8_MMA(1, 1, At, B1); PG8_BAR; PG8_SCHED;
            PG8_LDB(B0, 1, 0); PG8_LDB(B1, 1, 1); PG8_SCHED; PG8_LDA(At, 1, 0); PG8_STAGE(PG8_SA(0, 1), a2 + hstepA, voffA);
            PG8_WAIT_V(8); PG8_WAIT_L(0); PG8_BAR; PG8_MMA(0, 0, At, B0); PG8_MMA(0, 1, At, B1); PG8_BAR; PG8_SCHED;
            PG8_LDA(At, 1, 1); PG8_STAGE(PG8_SB(1, 0), b3, voffB); PG8_STAGE(PG8_SB(1, 1), b3 + hstepB, voffB); PG8_STAGE(PG8_SA(1, 0), a3, voffA);
            PG8_WAIT_V(8); PG8_WAIT_L(0); PG8_BAR; PG8_MMA(1, 0, At, B0); PG8_MMA(1, 1, At, B1); PG8_BAR; PG8_SCHED;
            if (t == 0 && ui > 0) E.publish(prev, lane);
        }
        if (wr == 0 && (!has_next || Epi::ALIGN_EPI)) PG8_BAR;
        if constexpr (!Epi::AFTER_DRAIN) E(acc, cur, wr, wc, fr, fq);
        if (!has_next) break;
#pragma unroll
        for (int a = 0; a < 2; ++a)
#pragma unroll
            for (int b = 0; b < 2; ++b)
#pragma unroll
                for (int m = 0; m < 4; ++m)
#pragma unroll
                    for (int n = 0; n < 2; ++n) acc[a][b][m][n] = (f32x4){0.f, 0.f, 0.f, 0.f};
        prev = cur; cur = nxt; cA = nA; cB = nB; ++ui;
        if (wr == 1 && Epi::ALIGN_EPI) PG8_BAR;
    }
    PG8_WAIT_V(0);
    E.publish(cur, lane);
    PG8_BAR;
    if constexpr (Epi::AFTER_DRAIN) E.fused(acc, cur, wr, wc, fr, fq, lds, wid, lane);
#undef PG8_SA
#undef PG8_SB
#undef PG8_STAGE
#undef PG8_LDA
#undef PG8_LDB
#undef PG8_MMA
#undef PG8_WAIT_V
#undef PG8_WAIT_L
#undef PG8_BAR
#undef PG8_SCHED
}
}


#define XB_TMO      128
#define XB_XCNT(j)  (256  + 64 * (j))
#define XB_XSUB(j)  (1280 + 64 * (j))
#define XB_XGEN(j)  (2304 + 64 * (j))
#define XB_TOP      3328
#define XB_TOPGEN   3392
#define XCD_BAR_WORDS 3456
#define XB_SPIN_CAP (1u << 18)
constexpr int CW_BAR = 4096;
__device__ __forceinline__ unsigned xb_ld(unsigned* p)              { return __hip_atomic_load(p, __ATOMIC_RELAXED, __HIP_MEMORY_SCOPE_AGENT); }
__device__ __forceinline__ unsigned xb_add(unsigned* p, unsigned v) { return __hip_atomic_fetch_add(p, v, __ATOMIC_RELAXED, __HIP_MEMORY_SCOPE_AGENT); }
__device__ __forceinline__ unsigned xb_xcc_id() { return (unsigned)__builtin_amdgcn_s_getreg((3 << 11) | 20) & 0xFu; }
#define XB_SPIN(cond, bar) do { unsigned _sp = 0; while (cond) { __builtin_amdgcn_s_sleep(1); \
    if ((++_sp & 255u) == 0u) { if (xb_ld(&(bar)[XB_TMO])) break; if (_sp > XB_SPIN_CAP) { atomicAdd(&(bar)[XB_TMO], 1u); break; } } } } while (0)
__device__ __forceinline__ void xcd_barrier_complete(unsigned* bar, unsigned x, unsigned& nloc, unsigned& nx) {
    const unsigned G = gridDim.x * gridDim.y * gridDim.z;
    unsigned sum, cnt, mine, sp = 0u;
    for (;;) {
        sum = 0u; cnt = 0u; mine = 0u;
#pragma unroll
        for (unsigned j = 0; j < 16; ++j) { const unsigned c = xb_ld(&bar[XB_XCNT(j)]); sum += c; cnt += (c > 0u) ? 1u : 0u; mine = (j == x) ? c : mine; }
        if (sum == G) break;
        __builtin_amdgcn_s_sleep(1);
        if ((++sp & 255u) == 0u) { if (xb_ld(&bar[XB_TMO])) break; if (sp > XB_SPIN_CAP) { atomicAdd(&bar[XB_TMO], 1u); break; } }
    }
    nloc = mine > 0u ? mine : 1u; nx = cnt > 0u ? cnt : 1u;
}
__device__ __forceinline__ void xcd_barrier(unsigned* bar, volatile LAS unsigned* st, bool tid0) {
    asm volatile("s_waitcnt vmcnt(0)" ::: "memory");
    __syncthreads();
    if (tid0) {
        const unsigned x = xb_xcc_id();
        __builtin_amdgcn_s_waitcnt(0);
        unsigned nloc = st[0], nx = st[1];
        if (nloc == 0u) { xcd_barrier_complete(bar, x, nloc, nx); st[0] = nloc; st[1] = nx; }
        const unsigned old = xb_add(&bar[XB_XSUB(x)], 1u);
        const unsigned gen = old / nloc;
        if (old + 1u == (gen + 1u) * nloc) {
            __builtin_amdgcn_fence(__ATOMIC_RELEASE, "agent");
            asm volatile("s_waitcnt vmcnt(0)" ::: "memory");
            const unsigned og = xb_add(&bar[XB_TOP], 1u);
            const unsigned tg = og / nx;
            if (og + 1u == (tg + 1u) * nx) xb_add(&bar[XB_TOPGEN], 1u);
            else XB_SPIN(xb_ld(&bar[XB_TOPGEN]) == tg, bar);
            __builtin_amdgcn_fence(__ATOMIC_ACQUIRE, "agent");
            xb_add(&bar[XB_XGEN(x)], 1u);
            asm volatile("s_waitcnt vmcnt(0)" ::: "memory");
        } else {
            XB_SPIN(xb_ld(&bar[XB_XGEN(x)]) == gen, bar);
            __builtin_amdgcn_fence(__ATOMIC_ACQUIRE, "agent");
            asm volatile("s_waitcnt vmcnt(0)" ::: "memory");
        }
    }
    __syncthreads();
}

struct Args { const float* in[N_INPUTS]; float* out; unsigned char* ws; int ph_lo, ph_hi; };
typedef const float* const __attribute__((address_space(4)))* inptr_t;
typedef const __attribute__((address_space(4))) unsigned char* kptr_t;
struct Frame {
    LAS unsigned char* lds; inptr_t in; float* out; unsigned char* ws;
    int tid, lane, wave, G, bid;
    float* X; float* MOD; bf16 *W1, *W2, *WIN, *WB, *WO, *XN, *Y, *P, *H, *FEAT, *YP, *QN, *KN, *VT; float* MG; unsigned* ctl;
};

__device__ __forceinline__ void conv_item(const float* __restrict__ W, int Nsrc, int srccol0, int nvalid, int k0, bf16* WT, int ldd, int n0, LAS float* scr, int lane) {
    const int rr = lane >> 3, ch = lane & 7;
    f32x4 v[8];
    if (nvalid == 32 && ((Nsrc | srccol0) & 3) == 0) {
#pragma unroll
        for (int i = 0; i < 8; ++i) v[i] = *(const f32x4*)(W + (size_t)(k0 + 8 * i + rr) * Nsrc + srccol0 + 4 * ch);
    } else {
#pragma unroll
        for (int i = 0; i < 8; ++i) { const float* p = W + (size_t)(k0 + 8 * i + rr) * Nsrc + srccol0 + 4 * ch;
#pragma unroll
            for (int e = 0; e < 4; ++e) v[i][e] = (4 * ch + e < nvalid) ? p[e] : 0.f; }
    }
#pragma unroll
    for (int i = 0; i < 8; ++i) { LAS float* s = scr + (8 * i + rr) * 33 + 4 * ch; s[0] = v[i].x; s[1] = v[i].y; s[2] = v[i].z; s[3] = v[i].w; }
    LDS_WAIT(); asm volatile("" ::: "memory");
    const int c = lane & 7;
#pragma unroll
    for (int jj = 0; jj < 4; ++jj) { const int n = (lane >> 3) + 8 * jj; const LAS float* s = scr + (8 * c) * 33 + n;
        u32x4 o; o.x = cvtpk(s[0 * 33], s[1 * 33]); o.y = cvtpk(s[2 * 33], s[3 * 33]); o.z = cvtpk(s[4 * 33], s[5 * 33]); o.w = cvtpk(s[6 * 33], s[7 * 33]);
        *(u32x4*)(WT + (size_t)(n0 + n) * ldd + k0 + 8 * c) = o; }
    LDS_WAIT(); asm volatile("" ::: "memory");
}
__device__ __forceinline__ void conv_matrix_item(const float* W, int K, int Nsrc, bf16* WT, int mode, int item, LAS float* scr, int lane) {
    const int nnb = ((Nsrc + 255) >> 8) * 8, nb = item % nnb, kb = item / nnb, n0 = nb * 32;
    int srccol0, nvalid;
    if (mode == 0) { srccol0 = n0; nvalid = Nsrc - n0; nvalid = nvalid < 0 ? 0 : (nvalid > 32 ? 32 : nvalid); }
    else { const int pn = n0 >> 8, rem = n0 & 255, bj = rem >> 7, jj = rem & 127; srccol0 = bj * FF + 128 * pn + jj; nvalid = 32; }
    conv_item(W, Nsrc, srccol0, nvalid, kb * 64, WT, K, n0, scr, lane);
}
__device__ __forceinline__ void conv_set(Frame& F, int l, int set) {
    LAS float* scr = (LAS float*)(F.lds + F.wave * 16384);
    const int gw = F.bid * 8 + F.wave, NGW = F.G * 8;
    constexpr int I_1 = 16 * 176, I_2 = 44 * 32, I_IN = 16 * 240, I_B = 4 * 32, I_O = 16 * 32;
    const int s = set;
    const float* w1 = F.in[I_FW1] + ((size_t)(l * 2 + s)) * 1024 * 5632;
    const float* w2 = F.in[I_FW2] + ((size_t)(l * 2 + s)) * FF * 1024;
    const int total = (set == 0) ? (I_1 + I_2 + I_IN + 4 * I_B + I_O) : (I_1 + I_2);
    for (int it = gw; it < total; it += NGW) {
        int r = it;
        if (r < I_1) { conv_matrix_item(w1, 1024, 5632, F.W1, 1, r, scr, F.lane); continue; } r -= I_1;
        if (r < I_2) { conv_matrix_item(w2, FF, 1024, F.W2, 0, r, scr, F.lane); continue; } r -= I_2;
        if (r < I_IN) { conv_matrix_item(F.in[I_WIN] + (size_t)l * 1024 * NIN, 1024, NIN, F.WIN, 0, r, scr, F.lane); continue; } r -= I_IN;
        if (r < 4 * I_B) { const int m = r / I_B; conv_matrix_item(F.in[I_WBR] + ((size_t)(l * 4 + m)) * 256 * 1024, 256, 1024, F.WB + (size_t)m * 1024 * 256, 0, r % I_B, scr, F.lane); continue; } r -= 4 * I_B;
        conv_matrix_item(F.in[I_WOUT] + (size_t)l * 1024 * 1024, 1024, 1024, F.WO, 0, r, scr, F.lane);
    }
}

struct CvArgs { const float* W; int Nsrc, srccol0, nvalid, k0; bf16* WT; int ldd, n0; };
__device__ __forceinline__ CvArgs cv_matrix(const float* W, int K, int Nsrc, bf16* WT, int mode, int item) {
    const int nnb = ((Nsrc + 255) >> 8) * 8, nb = item % nnb, kb = item / nnb, n0 = nb * 32;
    CvArgs a; a.W = W; a.Nsrc = Nsrc; a.k0 = kb * 64; a.WT = WT; a.ldd = K; a.n0 = n0;
    if (mode == 0) { a.srccol0 = n0; int nv = Nsrc - n0; a.nvalid = nv < 0 ? 0 : (nv > 32 ? 32 : nv); }
    else { const int pn = n0 >> 8, rem = n0 & 255, bj = rem >> 7, jj = rem & 127; a.srccol0 = bj * FF + 128 * pn + jj; a.nvalid = 32; }
    return a;
}
__device__ __forceinline__ void cv_load(const CvArgs& a, int lane, f32x4 (&v)[8]) {
    const int rr = lane >> 3, ch = lane & 7;
    if (a.nvalid == 32 && ((a.Nsrc | a.srccol0) & 3) == 0) {
#pragma unroll
        for (int i = 0; i < 8; ++i) v[i] = *(const f32x4*)(a.W + (size_t)(a.k0 + 8 * i + rr) * a.Nsrc + a.srccol0 + 4 * ch);
    } else {
#pragma unroll
        for (int i = 0; i < 8; ++i) { const float* p = a.W + (size_t)(a.k0 + 8 * i + rr) * a.Nsrc + a.srccol0 + 4 * ch;
#pragma unroll
            for (int e = 0; e < 4; ++e) v[i][e] = (4 * ch + e < a.nvalid) ? p[e] : 0.f; }
    }
}
__device__ __forceinline__ void cv_store(const CvArgs& a, LAS float* scr, int lane, const f32x4 (&v)[8]) {
    const int rr = lane >> 3, ch = lane & 7;
#pragma unroll
    for (int i = 0; i < 8; ++i) { LAS float* s = scr + (8 * i + rr) * 33 + 4 * ch; s[0] = v[i].x; s[1] = v[i].y; s[2] = v[i].z; s[3] = v[i].w; }
    LDS_WAIT(); asm volatile("" ::: "memory");
    const int c = lane & 7;
#pragma unroll
    for (int jj = 0; jj < 4; ++jj) { const int n = (lane >> 3) + 8 * jj; const LAS float* s = scr + (8 * c) * 33 + n;
        u32x4 o; o.x = cvtpk(s[0 * 33], s[1 * 33]); o.y = cvtpk(s[2 * 33], s[3 * 33]); o.z = cvtpk(s[4 * 33], s[5 * 33]); o.w = cvtpk(s[6 * 33], s[7 * 33]);
        *(u32x4*)(a.WT + (size_t)(a.n0 + n) * a.ldd + a.k0 + 8 * c) = o; }
    LDS_WAIT(); asm volatile("" ::: "memory");
}
__device__ __forceinline__ int cv_total(int what) {
    constexpr int I_1 = 16 * 176, I_2 = 44 * 32, I_IN = 16 * 240, I_B = 4 * 32, I_O = 16 * 32;
    return what == 0 ? I_1 + I_2 : what == 1 ? I_1 + I_2 + I_IN + 4 * I_B + I_O : what == 2 ? I_IN + 4 * I_B : what == 3 ? I_1 + I_2 + I_O : what == 4 ? I_1 + I_2 : I_IN + 4 * I_B + I_O;
}
__device__ __forceinline__ CvArgs cv_decode(Frame& F, int l, int what, int it) {
    constexpr int I_1 = 16 * 176, I_2 = 44 * 32, I_IN = 16 * 240, I_B = 4 * 32;
    bf16* W1b = (bf16*)(F.ws + WS_P); bf16* W2b = (bf16*)(F.ws + WS_P + 11 * MiB);
    int r = it;
    if (what == 0) {
        if (r < I_1) return cv_matrix(F.in[I_FW1] + ((size_t)(l * 2 + 1)) * 1024 * 5632, 1024, 5632, F.W1, 1, r);
        return cv_matrix(F.in[I_FW2] + ((size_t)(l * 2 + 1)) * FF * 1024, FF, 1024, F.W2, 0, r - I_1);
    }
    if (what != 2 && what != 5) {
        if (r < I_1) return cv_matrix(F.in[I_FW1] + ((size_t)(l * 2)) * 1024 * 5632, 1024, 5632, W1b, 1, r); r -= I_1;
        if (r < I_2) return cv_matrix(F.in[I_FW2] + ((size_t)(l * 2)) * FF * 1024, FF, 1024, W2b, 0, r); r -= I_2;
    }
    if (what != 3 && what != 4) {
        if (r < I_IN) return cv_matrix(F.in[I_WIN] + (size_t)l * 1024 * NIN, 1024, NIN, F.WIN, 0, r); r -= I_IN;
        if (r < 4 * I_B) { const int m = r / I_B; return cv_matrix(F.in[I_WBR] + ((size_t)(l * 4 + m)) * 256 * 1024, 256, 1024, F.WB + (size_t)m * 1024 * 256, 0, r % I_B); } r -= 4 * I_B;
    }
    return cv_matrix(F.in[I_WOUT] + (size_t)l * 1024 * 1024, 1024, 1024, F.WO, 0, r);
}
__device__ __forceinline__ void conv_stride(Frame& F, int l, int what, int w, int stride) {
    LAS float* scr = (LAS float*)(F.lds + F.wave * 16384);
    const int total = cv_total(what);
    if (w >= total) return;
    CvArgs aA = cv_decode(F, l, what, w), aB = aA; f32x4 vA[8], vB[8]; cv_load(aA, F.lane, vA);
    int it = w;
    for (;;) {
        int nx = it + stride;
        if (nx < total) { aB = cv_decode(F, l, what, nx); cv_load(aB, F.lane, vB); }
        cv_store(aA, scr, F.lane, vA);
        if (nx >= total) break;
        it = nx; nx = it + stride;
        if (nx < total) { aA = cv_decode(F, l, what, nx); cv_load(aA, F.lane, vA); }
        cv_store(aB, scr, F.lane, vB);
        if (nx >= total) break;
        it = nx;
    }
}
__device__ __forceinline__ void conv_idle(Frame& F, int l, int what, int mode) {
    if (F.G != 256) { conv_stride(F, l, what, F.bid * 8 + F.wave, F.G * 8); return; }
    if (mode == 0) { if (F.bid >= 192) conv_stride(F, l, what, (F.bid - 192) * 8 + F.wave, 512); return; }
    if (F.bid < 32) conv_stride(F, l, what, F.bid * 8 + F.wave, 768);
    else if (F.bid < 64) { const int s0 = 256 + (F.bid - 32) * 16 + F.wave * 2; conv_stride(F, l, what, s0, 768); conv_stride(F, l, what, s0 + 1, 768); }
}

__device__ __forceinline__ void mod_item(Frame& F, int item) {
    LAS float* sc = (LAS float*)F.lds;
    LAS float* red = (LAS float*)(F.lds + 36864);
    const int l = item / 36, g = item % 36, col = 256 * g + 4 * F.lane;
    const float* W = F.in[I_WMOD] + (size_t)l * 1024 * 9216 + col;
    f32x4 acc[9];
#pragma unroll
    for (int c = 0; c < 9; ++c) acc[c] = (f32x4){0.f, 0.f, 0.f, 0.f};
    f32x4 wA[8], wB[8];
#define MOD_LOAD(w_, kb_) do { const int k0_ = F.wave * 128 + (kb_) * 8; _Pragma("unroll") for (int i = 0; i < 8; ++i) w_[i] = *(const f32x4*)(W + (size_t)(k0_ + i) * 9216); } while (0)
#define MOD_FMA(w_, kb_) do { const int k0_ = F.wave * 128 + (kb_) * 8; _Pragma("unroll") for (int i = 0; i < 8; ++i) _Pragma("unroll") for (int c = 0; c < 9; ++c) acc[c] += w_[i] * sc[c * 1024 + k0_ + i]; __builtin_amdgcn_sched_barrier(0); } while (0)
    MOD_LOAD(wA, 0);
#pragma unroll 1
    for (int kb = 0; kb < 16; kb += 2) {
        MOD_LOAD(wB, kb + 1); __builtin_amdgcn_sched_barrier(0);
        MOD_FMA(wA, kb);
        if (kb + 2 < 16) MOD_LOAD(wA, kb + 2);
        __builtin_amdgcn_sched_barrier(0);
        MOD_FMA(wB, kb + 1);
    }
#undef MOD_LOAD
#undef MOD_FMA
#pragma unroll
    for (int c = 0; c < 9; ++c) *(LAS f32x4*)(red + (F.wave * 9 + c) * 256 + 4 * F.lane) = acc[c];
    __syncthreads();
    for (int idx = F.tid; idx < 9 * 256; idx += 512) { const int c = idx >> 8, j = idx & 255; float s = 0.f;
#pragma unroll
        for (int w = 0; w < 8; ++w) s += red[(w * 9 + c) * 256 + j];
        F.MOD[(size_t)(l * 9 + c) * 9216 + 256 * g + j] = s + F.in[I_BMOD][l * 9216 + 256 * g + j]; }
    __syncthreads();
}
__device__ __forceinline__ void mod_layer(Frame& F, int layer, int base) {
    const bool split = (F.G == 256);
    if (split && (F.bid < base || F.bid >= base + 36)) return;
    LAS float* sc = (LAS float*)F.lds;
    __syncthreads();
    for (int idx = F.tid; idx < 9 * 1024; idx += 512) { const int c = idx >> 10, k = idx & 1023; const float v = (c == 0) ? F.in[I_CCTX][k] : F.in[I_C][(c - 1) * 1024 + k]; sc[idx] = siluf(v); }
    __syncthreads();
    if (split) mod_item(F, layer * 36 + (F.bid - base));
    else for (int item = F.bid; item < 36; item += F.G) mod_item(F, layer * 36 + item);
    __syncthreads();
}
__device__ __forceinline__ void phase0(Frame& F) {
    mod_layer(F, 0, 0);
    if (F.G == 256) { if (F.bid >= 36) conv_stride(F, 0, 4, (F.bid - 36) * 8 + F.wave, (256 - 36) * 8); }
    else conv_stride(F, 0, 4, F.bid * 8 + F.wave, F.G * 8);
}

__device__ __forceinline__ int cond_of_row(int row) { return row < MC ? 0 : 1 + ((row - MC) >> 10); }
__device__ __forceinline__ void norm_phase(Frame& F, int l, int i, bool srcX, bool final_) {
    const int gw = F.bid * 8 + F.wave, NGW = F.G * 8;
    const float* g = final_ ? F.in[I_FNG] : F.in[I_NG] + (l * 3 + i) * 1024;
    for (int row = gw; row < M; row += NGW) {
        const float* xr = srcX ? F.X + (size_t)row * D : (row < MC ? F.in[I_XP] + (size_t)row * D : F.in[I_XS] + (size_t)(row - MC) * D);
        f32x4 v[4]; float ss = 0.f;
#pragma unroll
        for (int j = 0; j < 4; ++j) { v[j] = *(const f32x4*)(xr + 4 * F.lane + 256 * j); ss += (v[j].x * v[j].x + v[j].y * v[j].y) + (v[j].z * v[j].z + v[j].w * v[j].w); }
        const float rstd = rsqrtf(wave_sum(ss) * (1.f / 1024.f) + 1e-6f);
        if (final_) {
#pragma unroll
            for (int j = 0; j < 4; ++j) { const f32x4 gg = *(const f32x4*)(g + 4 * F.lane + 256 * j); *(f32x4*)(F.X + (size_t)row * D + 4 * F.lane + 256 * j) = v[j] * rstd * gg; }
        } else {
            const float* mp = F.MOD + (size_t)(l * 9 + cond_of_row(row)) * 9216 + (3 * i) * 1024;
#pragma unroll
            for (int j = 0; j < 4; ++j) { const int c = 4 * F.lane + 256 * j; const f32x4 gg = *(const f32x4*)(g + c), sh = *(const f32x4*)(mp + c), scl = *(const f32x4*)(mp + 1024 + c);
                const f32x4 o = v[j] * rstd * gg * (scl + 1.f) + sh; st_bf4(F.XN + (size_t)row * D + c, o); }
        }
    }
}

__device__ __forceinline__ void row_geom(int row, int& s, int& t, int& T) { if (row < MC) { s = row >> 8; t = row & 255; T = 256; } else { s = 16 + ((row - MC) >> 10); t = (row - MC) & 1023; T = 1024; } }
__device__ __forceinline__ int seq_row0(int s) { return s < 16 ? s * 256 : MC + (s - 16) * 1024; }
__device__ __forceinline__ int kv_row(int s, int kvh) { return s < 16 ? (s * 2 + kvh) * 256 : 8192 + ((s - 16) * 2 + kvh) * 1280; }
__device__ __forceinline__ f32x4 shift4(const bf16* P, const float* mu, int row, int col, bool hasp, bool hasn) {
    const f32x4 p = ld_bf4(P + (size_t)row * NP + col);
    const f32x4 z = (f32x4){0.f, 0.f, 0.f, 0.f};
    const f32x4 pp = hasp ? ld_bf4(P + (size_t)(row - 1) * NP + col) : z;
    const f32x4 pn = hasn ? ld_bf4(P + (size_t)(row + 1) * NP + col) : z;
    const f32x4 m = *(const f32x4*)(mu + col);
    return p + m * ((pp + pn) * 0.5f - p);
}
__device__ __forceinline__ float shift1(const bf16* P, const float* mu, int row, int col, bool hasp, bool hasn) {
    const float p = bf2f(P[(size_t)row * NP + col]);
    const float pp = hasp ? bf2f(P[(size_t)(row - 1) * NP + col]) : 0.f;
    const float pn = hasn ? bf2f(P[(size_t)(row + 1) * NP + col]) : 0.f;
    return p + mu[col] * (0.5f * (pp + pn) - p);
}

__device__ __forceinline__ float sum4q(f32x4 v) { return (v.x * v.x + v.y * v.y) + (v.z * v.z + v.w * v.w); }
__device__ __forceinline__ float swz_xor4(float v) { return __int_as_float(__builtin_amdgcn_ds_swizzle(__float_as_int(v), 0x101F)); }
__device__ __forceinline__ void pre_phase(Frame& F, int l) {
    const int gw = F.bid * 8 + F.wave, NGW = F.G * 8, lane = F.lane;
    bf16* LI = F.XN;
    {
        const float* mu = F.in[I_MU] + l * 1184 + 768 + 8 * lane;
        f32x4 m0 = (f32x4){0.f, 0.f, 0.f, 0.f}, m1 = m0;
        if (lane < 52) { m0 = *(const f32x4*)mu; m1 = *(const f32x4*)(mu + 4); }
        for (int rowb = gw; rowb < M; rowb += 3 * NGW) {
            u32x2 w[3][6]; bool ok[3];
#pragma unroll
            for (int q = 0; q < 3; ++q) {
                const int row = rowb + q * NGW; ok[q] = row < M;
#pragma unroll
                for (int j = 0; j < 6; ++j) w[q][j] = (u32x2){0u, 0u};
                if (ok[q] && lane < 52) {
                    int s, t, T; row_geom(row, s, t, T);
                    const bf16* p = F.P + (size_t)row * NP + 768 + 8 * lane;
                    w[q][0] = *(const u32x2*)p; w[q][1] = *(const u32x2*)(p + 4);
                    if (t > 0) { w[q][2] = *(const u32x2*)(p - NP); w[q][3] = *(const u32x2*)(p - NP + 4); }
                    if (t < T - 1) { w[q][4] = *(const u32x2*)(p + NP); w[q][5] = *(const u32x2*)(p + NP + 4); }
                }
            }
#pragma unroll
            for (int q = 0; q < 3; ++q) {
                if (!ok[q]) continue;
                const int row = rowb + q * NGW;
                u32x4 o = (u32x4){0u, 0u, 0u, 0u};
                if (lane < 52) {
                    const f32x4 c0 = unbf4_(w[q][0]), c1 = unbf4_(w[q][1]), p0 = unbf4_(w[q][2]), p1 = unbf4_(w[q][3]), n0 = unbf4_(w[q][4]), n1 = unbf4_(w[q][5]);
                    f32x4 x0 = c0 + m0 * ((p0 + n0) * 0.5f - c0), x1 = c1 + m1 * ((p1 + n1) * 0.5f - c1);
                    if (lane < 16) { x0 = (f32x4){tanhf_(x0.x), tanhf_(x0.y), tanhf_(x0.z), tanhf_(x0.w)}; x1 = (f32x4){tanhf_(x1.x), tanhf_(x1.y), tanhf_(x1.z), tanhf_(x1.w)}; }
                    else if (lane >= 32) { x0 = (f32x4){sigm(x0.x), sigm(x0.y), sigm(x0.z), sigm(x0.w)}; x1 = (f32x4){sigm(x1.x), sigm(x1.y), sigm(x1.z), sigm(x1.w)}; }
                    o.x = cvtpk(x0.x, x0.y); o.y = cvtpk(x0.z, x0.w); o.z = cvtpk(x1.x, x1.y); o.w = cvtpk(x1.z, x1.w);
                }
                *(u32x4*)(LI + (size_t)row * 512 + 8 * lane) = o;
            }
        }
    }
    {
        const int d4 = 4 * (lane & 15);
        const f32x4 qg = *(const f32x4*)(F.in[I_QN] + l * 64 + d4), kg = *(const f32x4*)(F.in[I_KN] + l * 64 + d4);
        f32x4 invf;
#pragma unroll
        for (int e = 0; e < 4; ++e) invf[e] = __builtin_amdgcn_exp2f(-(float)((d4 + e) & 15) * 0.83048202372f) * 0.15915494309f;
        for (int grp = gw; grp < M / 8 + 256; grp += NGW) {
            if (grp < M / 8) {
                const int rowb = grp * 8; int s, tb, T; row_geom(rowb, s, tb, T);
                const bool lat = rowb >= MC; const int koff = lat ? 256 : 0, L = lat ? 1280 : 256;
                const int kvh = (lane >> 4) & 1;
                u32x2 vraw[8];
#pragma unroll
                for (int j = 0; j < 8; ++j) {
                    const int row = rowb + j, t = tb + j;
                    f32x4 cs = (f32x4){1.f, 1.f, 1.f, 1.f}, sn = (f32x4){0.f, 0.f, 0.f, 0.f};
                    if (lat) { const float pos = (float)(((lane & 15) < 8) ? (t >> 6) : (t & 63));
#pragma unroll
                        for (int e = 0; e < 4; ++e) { const float rev = pos * invf[e]; sn[e] = __builtin_amdgcn_sinf(rev); cs[e] = __builtin_amdgcn_cosf(rev); } }
                    {
                        const f32x4 x = ld_bf4(F.P + (size_t)row * NP + PD + 4 * lane);
                        const float ss = row16_sum(sum4q(x));
                        f32x4 y = x * rsqrtf(ss * (1.f / 64.f) + 1e-6f) * qg;
                        if (lat) { f32x4 pr; pr.x = swz_xor4(y.x); pr.y = swz_xor4(y.y); pr.z = swz_xor4(y.z); pr.w = swz_xor4(y.w); y = (lane & 4) ? (y * cs + pr * sn) : (y * cs - pr * sn); }
                        st_bf4(F.QN + (size_t)row * 256 + 4 * lane, y * 0.18033688011f);
                    }
                    {
                        const u32x2 raw = *(const u32x2*)(F.P + (size_t)row * NP + PD + 256 + 4 * lane);
                        vraw[j] = raw;
                        f32x4 x; x.x = __uint_as_float(raw.x << 16); x.y = __uint_as_float(raw.x & 0xffff0000u); x.z = __uint_as_float(raw.y << 16); x.w = __uint_as_float(raw.y & 0xffff0000u);
                        const float ss = row16_sum(sum4q(x));
                        f32x4 y = x * rsqrtf(ss * (1.f / 64.f) + 1e-6f) * kg;
                        if (lane < 32) {
                            if (!lat) *(f32x4*)(F.out + O_CK + ((((size_t)s * 2 + l) * 256 + t) * 2 + kvh) * 64 + d4) = y;
                        } else {
                            if (!lat) *(f32x4*)(F.out + O_CV + ((((size_t)s * 2 + l) * 256 + t) * 2 + kvh) * 64 + d4) = x;
                        }
                        if (lat) { f32x4 pr; pr.x = swz_xor4(y.x); pr.y = swz_xor4(y.y); pr.z = swz_xor4(y.z); pr.w = swz_xor4(y.w); y = (lane & 4) ? (y * cs + pr * sn) : (y * cs - pr * sn); }
                        if (lane < 32) st_bf4(F.KN + (size_t)(kv_row(s, kvh) + koff + t) * 64 + d4, y);
                    }
                }
                if (lane >= 32) {
                    bf16* vb = F.VT + (size_t)kv_row(s, kvh) * 64 + koff + tb;
#pragma unroll
                    for (int e = 0; e < 4; ++e) {
                        u32x4 w;
                        if (e == 0) { w.x = (vraw[0].x & 0xffffu) | (vraw[1].x << 16); w.y = (vraw[2].x & 0xffffu) | (vraw[3].x << 16); w.z = (vraw[4].x & 0xffffu) | (vraw[5].x << 16); w.w = (vraw[6].x & 0xffffu) | (vraw[7].x << 16); }
                        else if (e == 1) { w.x = (vraw[0].x >> 16) | (vraw[1].x & 0xffff0000u); w.y = (vraw[2].x >> 16) | (vraw[3].x & 0xffff0000u); w.z = (vraw[4].x >> 16) | (vraw[5].x & 0xffff0000u); w.w = (vraw[6].x >> 16) | (vraw[7].x & 0xffff0000u); }
                        else if (e == 2) { w.x = (vraw[0].y & 0xffffu) | (vraw[1].y << 16); w.y = (vraw[2].y & 0xffffu) | (vraw[3].y << 16); w.z = (vraw[4].y & 0xffffu) | (vraw[5].y << 16); w.w = (vraw[6].y & 0xffffu) | (vraw[7].y << 16); }
                        else { w.x = (vraw[0].y >> 16) | (vraw[1].y & 0xffff0000u); w.y = (vraw[2].y >> 16) | (vraw[3].y & 0xffff0000u); w.z = (vraw[4].y >> 16) | (vraw[5].y & 0xffff0000u); w.w = (vraw[6].y >> 16) | (vraw[7].y & 0xffff0000u); }
                        *(u32x4*)(vb + (size_t)(d4 + e) * L) = w;
                    }
                }
            } else {
                const int cg8 = grp - M / 8, b = cg8 >> 5, jb = (cg8 & 31) * 8, kvh = (lane >> 4) & 1;
                f32x4 xv[8];
#pragma unroll
                for (int j = 0; j < 8; ++j) {
                    const size_t src = ((((size_t)b * 2 + l) * 256 + jb + j) * 2 + kvh) * 64 + d4;
                    xv[j] = (lane < 32) ? *(const f32x4*)(F.in[I_CK] + src) : *(const f32x4*)(F.in[I_CV] + src);
                    if (lane < 32) st_bf4(F.KN + (size_t)(kv_row(16 + b, kvh) + jb + j) * 64 + d4, xv[j]);
                }
                if (lane >= 32) {
                    bf16* vb = F.VT + (size_t)kv_row(16 + b, kvh) * 64 + jb;
#pragma unroll
                    for (int e = 0; e < 4; ++e) { u32x4 w; w.x = pk2(xv[0][e], xv[1][e]); w.y = pk2(xv[2][e], xv[3][e]); w.z = pk2(xv[4][e], xv[5][e]); w.w = pk2(xv[6][e], xv[7][e]);
                        *(u32x4*)(vb + (size_t)(d4 + e) * 1280) = w; }
                }
            }
        }
    }
    {
        bf16* WL = (bf16*)(F.ws + WS_WL);
        for (int idx = (F.bid * 512 + F.tid) * 2; idx < 1280 * 512; idx += F.G * 1024) {
            const int n = idx >> 9, k = idx & 511, blk = n >> 8, nn = n & 255;
            float v0 = 0.f, v1 = 0.f;
            if (blk < 4) { const int k0 = blk * 64; const float* W = ((blk < 2) ? F.in[I_WUP] : F.in[I_AUP]) + (size_t)(l * 2 + (blk & 1)) * 64 * 256;
                if (k >= k0 && k < k0 + 64) { v0 = W[(size_t)(k - k0) * 256 + nn]; v1 = W[(size_t)(k + 1 - k0) * 256 + nn]; } }
            else { const float* W = F.in[I_GUP] + (size_t)l * 160 * 256; if (k >= 256 && k < 416) { v0 = W[(size_t)(k - 256) * 256 + nn]; v1 = W[(size_t)(k - 255) * 256 + nn]; } }
            *(unsigned*)(WL + idx) = pk2(v0, v1);
        }
    }
}

constexpr int OPSZ = 2048, BUFSZ = 6 * OPSZ;
__device__ __forceinline__ float red8(float v) { v += DPPF(v, 0xB1); v += DPPF(v, 0x4E); v += DPPF(v, 0x141); return v; }
__device__ __forceinline__ f32x2 fma2(f32x2 a, f32x2 b, f32x2 c) { return __builtin_elementwise_fma(a, b, c); }


struct OpsR { f32x4 wa, wb, ka, kb, aa, ab, da, db, ra, rb; f32x2 val; };
__device__ __forceinline__ void ld_rwkv(OpsR& o, const LAS float* op, int ti, int seg, int rp) {
    const LAS float* pb = op + ti * 64 + 8 * seg;
    o.wa = *(const LAS f32x4*)(pb); o.wb = *(const LAS f32x4*)(pb + 4);
    o.ka = *(const LAS f32x4*)(pb + OPSZ); o.kb = *(const LAS f32x4*)(pb + OPSZ + 4);
    o.aa = *(const LAS f32x4*)(pb + 2 * OPSZ); o.ab = *(const LAS f32x4*)(pb + 2 * OPSZ + 4);
    o.da = *(const LAS f32x4*)(pb + 3 * OPSZ); o.db = *(const LAS f32x4*)(pb + 3 * OPSZ + 4);
    o.ra = *(const LAS f32x4*)(pb + 4 * OPSZ); o.rb = *(const LAS f32x4*)(pb + 4 * OPSZ + 4);
    o.val = *(const LAS f32x2*)(op + 5 * OPSZ + ti * 64 + 2 * rp);
}
__device__ __forceinline__ void step_rwkv(f32x2 (&S2)[2][4], const OpsR& o, LAS float* ydst) {
    const f32x2 w2[4] = {o.wa.xy, o.wa.zw, o.wb.xy, o.wb.zw}, kk2[4] = {o.ka.xy, o.ka.zw, o.kb.xy, o.kb.zw}, kka2[4] = {o.aa.xy, o.aa.zw, o.ab.xy, o.ab.zw},
                kd2[4] = {o.da.xy, o.da.zw, o.db.xy, o.db.zw}, r2[4] = {o.ra.xy, o.ra.zw, o.rb.xy, o.rb.zw};
    f32x2 d0 = S2[0][0] * kk2[0], d1 = S2[1][0] * kk2[0];
#pragma unroll
    for (int j = 1; j < 4; ++j) { d0 = fma2(S2[0][j], kk2[j], d0); d1 = fma2(S2[1][j], kk2[j], d1); }
    const float sa0 = -red8(d0.x + d0.y), sa1 = -red8(d1.x + d1.y);
    const f32x2 sa0v = (f32x2){sa0, sa0}, sa1v = (f32x2){sa1, sa1}, v0v = (f32x2){o.val.x, o.val.x}, v1v = (f32x2){o.val.y, o.val.y};
    f32x2 y0 = (f32x2){0.f, 0.f}, y1 = (f32x2){0.f, 0.f};
#pragma unroll
    for (int j = 0; j < 4; ++j) {
        const f32x2 t0 = fma2(sa0v, kka2[j], v0v * kd2[j]), t1 = fma2(sa1v, kka2[j], v1v * kd2[j]);
        S2[0][j] = fma2(S2[0][j], w2[j], t0); S2[1][j] = fma2(S2[1][j], w2[j], t1);
        y0 = fma2(S2[0][j], r2[j], y0); y1 = fma2(S2[1][j], r2[j], y1);
    }
    const float yy0 = red8(y0.x + y0.y), yy1 = red8(y1.x + y1.y);
    *(LAS f32x2*)ydst = (f32x2){yy0, yy1};
}
struct OpsD { f32x4 ka, kb, qa, qb; f32x2 val, eb; };
__device__ __forceinline__ void ld_delta(OpsD& o, const LAS float* op, const LAS float* scal, int ti, int seg, int rp) {
    const LAS float* pb = op + ti * 64 + 8 * seg;
    o.ka = *(const LAS f32x4*)(pb); o.kb = *(const LAS f32x4*)(pb + 4);
    o.qa = *(const LAS f32x4*)(pb + OPSZ); o.qb = *(const LAS f32x4*)(pb + OPSZ + 4);
    o.val = *(const LAS f32x2*)(op + 2 * OPSZ + ti * 64 + 2 * rp);
    o.eb = *(const LAS f32x2*)(scal + ti * 2);
}
__device__ __forceinline__ void step_delta(f32x2 (&S2)[2][4], const OpsD& o, LAS float* ydst) {
    const f32x2 k2[4] = {o.ka.xy, o.ka.zw, o.kb.xy, o.kb.zw}, q2[4] = {o.qa.xy, o.qa.zw, o.qb.xy, o.qb.zw};
    f32x2 d0 = S2[0][0] * k2[0], d1 = S2[1][0] * k2[0];
#pragma unroll
    for (int j = 1; j < 4; ++j) { d0 = fma2(S2[0][j], k2[j], d0); d1 = fma2(S2[1][j], k2[j], d1); }
    const float kS0 = red8(d0.x + d0.y), kS1 = red8(d1.x + d1.y);
    const float vn0 = o.eb.y * (o.val.x - o.eb.x * kS0), vn1 = o.eb.y * (o.val.y - o.eb.x * kS1);
    const f32x2 vn0v = (f32x2){vn0, vn0}, vn1v = (f32x2){vn1, vn1}, egv = (f32x2){o.eb.x, o.eb.x};
    f32x2 y0 = (f32x2){0.f, 0.f}, y1 = (f32x2){0.f, 0.f};
#pragma unroll
    for (int j = 0; j < 4; ++j) {
        S2[0][j] = fma2(S2[0][j], egv, k2[j] * vn0v); S2[1][j] = fma2(S2[1][j], egv, k2[j] * vn1v);
        y0 = fma2(S2[0][j], q2[j], y0); y1 = fma2(S2[1][j], q2[j], y1);
    }
    const float yy0 = red8(y0.x + y0.y), yy1 = red8(y1.x + y1.y);
    *(LAS f32x2*)ydst = (f32x2){yy0, yy1};
}
struct OpsG { f32x4 aa, ab, ka, kb, qa, qb; float val; };
__device__ __forceinline__ void ld_gla(OpsG& o, const LAS float* op, int ti, int seg, int rp) {
    const LAS float* pb = op + ti * 32 + 8 * seg;
    o.aa = *(const LAS f32x4*)(pb); o.ab = *(const LAS f32x4*)(pb + 4);
    o.ka = *(const LAS f32x4*)(pb + OPSZ); o.kb = *(const LAS f32x4*)(pb + OPSZ + 4);
    o.qa = *(const LAS f32x4*)(pb + 2 * OPSZ); o.qb = *(const LAS f32x4*)(pb + 2 * OPSZ + 4);
    o.val = op[3 * OPSZ + ti * 64 + rp];
}
__device__ __forceinline__ void step_gla(f32x2 (&S)[4], const OpsG& o, LAS float* ydst) {
    const f32x2 a2[4] = {o.aa.xy, o.aa.zw, o.ab.xy, o.ab.zw}, k2[4] = {o.ka.xy, o.ka.zw, o.kb.xy, o.kb.zw}, q2[4] = {o.qa.xy, o.qa.zw, o.qb.xy, o.qb.zw};
    const f32x2 vv = (f32x2){o.val, o.val};
    f32x2 y0 = (f32x2){0.f, 0.f};
#pragma unroll
    for (int j = 0; j < 4; ++j) { S[j] = fma2(S[j], a2[j], k2[j] * vv); y0 = fma2(S[j], q2[j], y0); }
    *ydst = quad_sum(y0.x + y0.y);
}

template <int MIX>
__device__ __forceinline__ void stage_chunk(Frame& F, int l, int dir, int h, int row0, int T, int tbase, LAS float* op, LAS float* scal, int st) {
    const int stok = st >> 3, sq = st & 7;
    const int t = tbase + stok, row = row0 + t; const bool hasp = t > 0, hasn = t < T - 1;
    if (MIX == 0) {
        const float* mu = F.in[I_MU] + l * 1184;
        f32x4 r4[2], k4[2], v4[2], E4[2], a4[2], kk4[2]; float ss = 0.f;
#pragma unroll
        for (int g = 0; g < 2; ++g) {
            const int c = h * 64 + 8 * sq + 4 * g;
            r4[g] = shift4(F.P, mu, row, PA + c, hasp, hasn); k4[g] = shift4(F.P, mu, row, PA + 256 + c, hasp, hasn); v4[g] = shift4(F.P, mu, row, PA + 512 + c, hasp, hasn);
            E4[g] = ld_bf4(F.FEAT + (size_t)row * NFEAT + dir * 256 + c); a4[g] = ld_bf4(F.FEAT + (size_t)row * NFEAT + 512 + dir * 256 + c);
            kk4[g] = k4[g] * *(const f32x4*)(F.in[I_KK] + l * 256 + c);
            ss += (kk4[g].x * kk4[g].x + kk4[g].y * kk4[g].y) + (kk4[g].z * kk4[g].z + kk4[g].w * kk4[g].w);
        }
        const float rn = rsqrtf(red8(ss) + 1e-6f);
#pragma unroll
        for (int g = 0; g < 2; ++g) {
            const int c = h * 64 + 8 * sq + 4 * g;
            const f32x4 kaw = *(const f32x4*)(F.in[I_KA] + l * 256 + c);
            const f32x4 kkn = kk4[g] * rn;
            f32x4 w4; w4.x = __expf(-E4[g].x); w4.y = __expf(-E4[g].y); w4.z = __expf(-E4[g].z); w4.w = __expf(-E4[g].w);
            const f32x4 kd4 = k4[g] * ((a4[g] - 1.f) * kaw + 1.f), kka4 = kkn * a4[g];
            const int o = stok * 64 + 8 * sq + 4 * g;
            *(LAS f32x4*)(op + 0 * OPSZ + o) = w4; *(LAS f32x4*)(op + 1 * OPSZ + o) = kkn; *(LAS f32x4*)(op + 2 * OPSZ + o) = kka4;
            *(LAS f32x4*)(op + 3 * OPSZ + o) = kd4; *(LAS f32x4*)(op + 4 * OPSZ + o) = r4[g]; *(LAS f32x4*)(op + 5 * OPSZ + o) = v4[g];
        }
    } else if (MIX == 1) {
        const float* cw = F.in[I_DCV] + l * 3 * 768;
        f32x4 o3[2][3]; float sq_ = 0.f, sk_ = 0.f;
#pragma unroll
        for (int g = 0; g < 2; ++g) {
            const int c = h * 64 + 8 * sq + 4 * g;
#pragma unroll
            for (int part = 0; part < 3; ++part) {
                const int cc = part * 256 + c, col = PC + cc;
                const f32x4 z = (f32x4){0.f, 0.f, 0.f, 0.f};
                const f32x4 xm = hasp ? ld_bf4(F.P + (size_t)(row - 1) * NP + col) : z, x0 = ld_bf4(F.P + (size_t)row * NP + col), xp = hasn ? ld_bf4(F.P + (size_t)(row + 1) * NP + col) : z;
                const f32x4 y = xm * *(const f32x4*)(cw + cc) + x0 * *(const f32x4*)(cw + 768 + cc) + xp * *(const f32x4*)(cw + 1536 + cc);
                f32x4 sy; sy.x = siluf(y.x); sy.y = siluf(y.y); sy.z = siluf(y.z); sy.w = siluf(y.w);
                o3[g][part] = sy;
            }
            sq_ += (o3[g][0].x * o3[g][0].x + o3[g][0].y * o3[g][0].y) + (o3[g][0].z * o3[g][0].z + o3[g][0].w * o3[g][0].w);
            sk_ += (o3[g][1].x * o3[g][1].x + o3[g][1].y * o3[g][1].y) + (o3[g][1].z * o3[g][1].z + o3[g][1].w * o3[g][1].w);
        }
        const float qn = rsqrtf(red8(sq_) + 1e-6f) * 0.125f, kn = rsqrtf(red8(sk_) + 1e-6f);
#pragma unroll
        for (int g = 0; g < 2; ++g) {
            const int o = stok * 64 + 8 * sq + 4 * g;
            *(LAS f32x4*)(op + 0 * OPSZ + o) = o3[g][1] * kn; *(LAS f32x4*)(op + 1 * OPSZ + o) = o3[g][0] * qn; *(LAS f32x4*)(op + 2 * OPSZ + o) = o3[g][2];
        }
        if (sq == 0) {
            const float bd = bf2f(F.P[(size_t)row * NP + PC + 1024 + dir * 4 + h]), ad = bf2f(F.P[(size_t)row * NP + PC + 1032 + dir * 4 + h]);
            const float gg = -__expf(F.in[I_DAL][(l * 2 + dir) * 4 + h]) * softplusf(ad + F.in[I_DDT][(l * 2 + dir) * 4 + h]);
            scal[stok * 2] = __expf(gg); scal[stok * 2 + 1] = sigm(bd);
        }
    } else {
        const int kx = 4 * sq;
        const f32x4 q4 = ld_bf4(F.P + (size_t)row * NP + PB + h * 32 + kx) * 0.17677669529f;
        const f32x4 k4 = ld_bf4(F.P + (size_t)row * NP + PB + 128 + h * 32 + kx);
        const float* au = F.in[I_GAU] + (size_t)(l * 2 + dir) * 16 * 128 + h * 32 + kx;
        f32x4 x4 = *(const f32x4*)(F.in[I_GAB] + (l * 2 + dir) * 128 + h * 32 + kx);
        const f32x4 ad0 = ld_bf4(F.P + (size_t)row * NP + PB + 512 + dir * 16), ad1 = ld_bf4(F.P + (size_t)row * NP + PB + 512 + dir * 16 + 4), ad2 = ld_bf4(F.P + (size_t)row * NP + PB + 512 + dir * 16 + 8), ad3 = ld_bf4(F.P + (size_t)row * NP + PB + 512 + dir * 16 + 12);
#pragma unroll
        for (int j = 0; j < 4; ++j) { x4 += *(const f32x4*)(au + j * 128) * ad0[j]; x4 += *(const f32x4*)(au + (4 + j) * 128) * ad1[j]; x4 += *(const f32x4*)(au + (8 + j) * 128) * ad2[j]; x4 += *(const f32x4*)(au + (12 + j) * 128) * ad3[j]; }
        f32x4 a4; a4.x = __expf(-softplusf(-x4.x) * (1.f / 16.f)); a4.y = __expf(-softplusf(-x4.y) * (1.f / 16.f)); a4.z = __expf(-softplusf(-x4.z) * (1.f / 16.f)); a4.w = __expf(-softplusf(-x4.w) * (1.f / 16.f));
        const int o = stok * 32 + kx;
        *(LAS f32x4*)(op + 0 * OPSZ + o) = a4; *(LAS f32x4*)(op + 1 * OPSZ + o) = k4; *(LAS f32x4*)(op + 2 * OPSZ + o) = q4;
        *(LAS f32x4*)(op + 3 * OPSZ + stok * 64 + 8 * sq) = ld_bf4(F.P + (size_t)row * NP + PB + 256 + h * 64 + 8 * sq);
        *(LAS f32x4*)(op + 3 * OPSZ + stok * 64 + 8 * sq + 4) = ld_bf4(F.P + (size_t)row * NP + PB + 256 + h * 64 + 8 * sq + 4);
    }
}

template <int MIX  >
__device__ __forceinline__ void scan_item(Frame& F, int l, int s, int dir, int h) {
    LAS float* lds = (LAS float*)F.lds;
    const int T = s < 16 ? 256 : 1024, row0 = seq_row0(s), nch = T / 32, tid = F.tid;
    const bool scanner = F.wave < 4;
    const int L = tid & 255, st = tid & 255;
    const int seg = (MIX == 2) ? (L & 3) : (L & 7), rp = (MIX == 2) ? (L >> 2) : (L >> 3);
    f32x2 S2[2][4];
#pragma unroll
    for (int r = 0; r < 2; ++r)
#pragma unroll
        for (int j = 0; j < 4; ++j) S2[r][j] = (f32x2){0.f, 0.f};
    if (scanner && s >= 16) {
        const int b = s - 16;
        if (MIX == 0) {
#pragma unroll
            for (int r = 0; r < 2; ++r) { const float* sp = F.in[I_SR] + ((((size_t)(b * 2 + l) * 2 + dir) * 4 + h) * 64 + 2 * rp + r) * 64 + 8 * seg;
#pragma unroll
                for (int j = 0; j < 4; ++j) S2[r][j] = *(const f32x2*)(sp + 2 * j); }
        } else if (MIX == 1) {
            const float* sp = F.in[I_SD] + (((size_t)(b * 2 + l) * 2 + dir) * 4 + h) * 64 * 64 + 2 * rp;
#pragma unroll
            for (int j = 0; j < 4; ++j) { const f32x2 lo = *(const f32x2*)(sp + (size_t)(8 * seg + 2 * j) * 64), hi = *(const f32x2*)(sp + (size_t)(8 * seg + 2 * j + 1) * 64);
                S2[0][j] = (f32x2){lo.x, hi.x}; S2[1][j] = (f32x2){lo.y, hi.y}; }
        } else {
            const float* sp = F.in[I_SG] + (((size_t)(b * 2 + l) * 2 + dir) * 4 + h) * 32 * 64 + rp;
#pragma unroll
            for (int j = 0; j < 4; ++j) S2[0][j] = (f32x2){sp[(size_t)(8 * seg + 2 * j) * 64], sp[(size_t)(8 * seg + 2 * j + 1) * 64]};
        }
    }
    if (scanner) __builtin_amdgcn_s_setprio(2);
    if (!scanner) stage_chunk<MIX>(F, l, dir, h, row0, T, dir == 0 ? 0 : T - 32, lds, lds + 2 * BUFSZ + 2 * OPSZ, st);
    __syncthreads();
    for (int ci = 0; ci < nch; ++ci) {
        const int tbase = dir == 0 ? 32 * ci : T - 32 * (ci + 1);
        LAS float* op = lds + (ci & 1) * BUFSZ; LAS float* ybuf = lds + 2 * BUFSZ + (ci & 1) * OPSZ; LAS float* scal = lds + 2 * BUFSZ + 2 * OPSZ + 64 * (ci & 1);
        if (scanner) {
            LAS float* ydum = lds + 2 * BUFSZ + 2 * OPSZ + 128 + 2 * L;
            if (MIX == 0) {
                OpsR A, B; ld_rwkv(A, op, dir == 0 ? 0 : 31, seg, rp);
#pragma unroll 1
                for (int i = 0; i < 32; i += 2) {
                    const int t0 = dir == 0 ? i : 31 - i, t1 = dir == 0 ? i + 1 : 30 - i, i2 = i + 2 < 32 ? i + 2 : 31, t2 = dir == 0 ? i2 : 31 - i2;
                    ld_rwkv(B, op, t1, seg, rp);
                    step_rwkv(S2, A, seg == 0 ? ybuf + t0 * 64 + 2 * rp : ydum);
                    ld_rwkv(A, op, t2, seg, rp);
                    step_rwkv(S2, B, seg == 0 ? ybuf + t1 * 64 + 2 * rp : ydum);
                }
            } else if (MIX == 1) {
                OpsD A, B; ld_delta(A, op, scal, dir == 0 ? 0 : 31, seg, rp);
#pragma unroll 1
                for (int i = 0; i < 32; i += 2) {
                    const int t0 = dir == 0 ? i : 31 - i, t1 = dir == 0 ? i + 1 : 30 - i, i2 = i + 2 < 32 ? i + 2 : 31, t2 = dir == 0 ? i2 : 31 - i2;
                    ld_delta(B, op, scal, t1, seg, rp);
                    step_delta(S2, A, seg == 0 ? ybuf + t0 * 64 + 2 * rp : ydum);
                    ld_delta(A, op, scal, t2, seg, rp);
                    step_delta(S2, B, seg == 0 ? ybuf + t1 * 64 + 2 * rp : ydum);
                }
            } else {
                OpsG A, B; ld_gla(A, op, dir == 0 ? 0 : 31, seg, rp);
#pragma unroll 1
                for (int i = 0; i < 32; i += 2) {
                    const int t0 = dir == 0 ? i : 31 - i, t1 = dir == 0 ? i + 1 : 30 - i, i2 = i + 2 < 32 ? i + 2 : 31, t2 = dir == 0 ? i2 : 31 - i2;
                    ld_gla(B, op, t1, seg, rp);
                    step_gla(S2[0], A, seg == 0 ? ybuf + t0 * 64 + rp : ydum);
                    ld_gla(A, op, t2, seg, rp);
                    step_gla(S2[0], B, seg == 0 ? ybuf + t1 * 64 + rp : ydum);
                }
            }
        } else {
            if (ci + 1 < nch) stage_chunk<MIX>(F, l, dir, h, row0, T, dir == 0 ? 32 * (ci + 1) : T - 32 * (ci + 2), lds + ((ci + 1) & 1) * BUFSZ, lds + 2 * BUFSZ + 2 * OPSZ + 64 * ((ci + 1) & 1), st);
            if (ci > 0) {
                const int pt = dir == 0 ? 32 * (ci - 1) : T - 32 * ci; const LAS float* yb = lds + 2 * BUFSZ + ((ci - 1) & 1) * OPSZ;
                const int tok = st >> 3, c8 = (st & 7) * 8;
                bf16* yo = F.YP + ((size_t)(MIX * 2 + dir) * M + row0 + pt + tok) * 256 + h * 64 + c8;
                st_bf4(yo, *(const LAS f32x4*)(yb + tok * 64 + c8)); st_bf4(yo + 4, *(const LAS f32x4*)(yb + tok * 64 + c8 + 4));
            }
        }
        __syncthreads();
    }
    if (scanner) __builtin_amdgcn_s_setprio(0);
    if (!scanner) {
        const int pt = dir == 0 ? 32 * (nch - 1) : 0; const LAS float* yb = lds + 2 * BUFSZ + ((nch - 1) & 1) * OPSZ;
        const int tok = st >> 3, c8 = (st & 7) * 8;
        bf16* yo = F.YP + ((size_t)(MIX * 2 + dir) * M + row0 + pt + tok) * 256 + h * 64 + c8;
        st_bf4(yo, *(const LAS f32x4*)(yb + tok * 64 + c8)); st_bf4(yo + 4, *(const LAS f32x4*)(yb + tok * 64 + c8 + 4));
    } else if (s < 16) {
        if (MIX == 0) {
#pragma unroll
            for (int r = 0; r < 2; ++r) { float* sp = F.out + O_SR + ((((size_t)(s * 2 + l) * 2 + dir) * 4 + h) * 64 + 2 * rp + r) * 64 + 8 * seg;
#pragma unroll
                for (int j = 0; j < 4; ++j) *(f32x2*)(sp + 2 * j) = S2[r][j]; }
        } else if (MIX == 1) {
            float* sp = F.out + O_SD + (((size_t)(s * 2 + l) * 2 + dir) * 4 + h) * 64 * 64 + 2 * rp;
#pragma unroll
            for (int j = 0; j < 4; ++j) { *(f32x2*)(sp + (size_t)(8 * seg + 2 * j) * 64) = (f32x2){S2[0][j].x, S2[1][j].x}; *(f32x2*)(sp + (size_t)(8 * seg + 2 * j + 1) * 64) = (f32x2){S2[0][j].y, S2[1][j].y}; }
        } else {
            float* sp = F.out + O_SG + (((size_t)(s * 2 + l) * 2 + dir) * 4 + h) * 32 * 64 + rp;
#pragma unroll
            for (int j = 0; j < 4; ++j) { sp[(size_t)(8 * seg + 2 * j) * 64] = S2[0][j].x; sp[(size_t)(8 * seg + 2 * j + 1) * 64] = S2[0][j].y; }
        }
    }
    __syncthreads();
}

#define CH_BAR() do { asm volatile("s_waitcnt lgkmcnt(0)" ::: "memory"); __builtin_amdgcn_s_barrier(); asm volatile("" ::: "memory"); } while (0)
constexpr int AT_P = 72;
constexpr int AT_TILE = 64 * AT_P;
__device__ __forceinline__ void attn_tile_lds(const LAS bf16* Kt, const LAS bf16* Vt, int sub, const bf16x8 (&qf)[4], f32x16& O0, f32x16& O1, float& mrun, float& lsum, int lane) {
    const int r = lane & 31, hh = lane >> 5;
    f32x16 st;
#pragma unroll
    for (int e = 0; e < 16; ++e) st[e] = 0.f;
#pragma unroll
    for (int ks = 0; ks < 4; ++ks) { const bf16x8 kf = *(const LAS bf16x8*)(Kt + (32 * sub + r) * AT_P + 16 * ks + 8 * hh); st = __builtin_amdgcn_mfma_f32_32x32x16_bf16(kf, qf[ks], st, 0, 0, 0); }
    float tmax = st[0];
#pragma unroll
    for (int e = 1; e < 16; ++e) tmax = fmaxf(tmax, st[e]);
    tmax = fmaxf(tmax, xor32(tmax, lane));
    const float mnew = fmaxf(mrun, tmax), alpha = __builtin_amdgcn_exp2f(mrun - mnew);
    mrun = mnew;
    float ps = 0.f;
#pragma unroll
    for (int e = 0; e < 16; ++e) { st[e] = __builtin_amdgcn_exp2f(st[e] - mnew); ps += st[e]; }
    lsum = lsum * alpha + ps;
#pragma unroll
    for (int e = 0; e < 16; ++e) { O0[e] *= alpha; O1[e] *= alpha; }
#pragma unroll
    for (int sx = 0; sx < 2; ++sx) {
        u32x4 pw; pw.x = cvtpk(st[8 * sx + 0], st[8 * sx + 1]); pw.y = cvtpk(st[8 * sx + 2], st[8 * sx + 3]); pw.z = cvtpk(st[8 * sx + 4], st[8 * sx + 5]); pw.w = cvtpk(st[8 * sx + 6], st[8 * sx + 7]);
        const bf16x8 pb = __builtin_bit_cast(bf16x8, pw);
        const LAS bf16* vp0 = Vt + r * AT_P + 32 * sub + 16 * sx + 4 * hh; const LAS bf16* vp1 = vp0 + 32 * AT_P;
        const bf16x8 v0 = __builtin_shufflevector(*(const LAS s16x4*)vp0, *(const LAS s16x4*)(vp0 + 8), 0, 1, 2, 3, 4, 5, 6, 7);
        const bf16x8 v1 = __builtin_shufflevector(*(const LAS s16x4*)vp1, *(const LAS s16x4*)(vp1 + 8), 0, 1, 2, 3, 4, 5, 6, 7);
        O0 = __builtin_amdgcn_mfma_f32_32x32x16_bf16(v0, pb, O0, 0, 0, 0);
        O1 = __builtin_amdgcn_mfma_f32_32x32x16_bf16(v1, pb, O1, 0, 0, 0);
    }
}
__device__ __forceinline__ void attn_item(Frame& F, int s, int kvh, int qc) {
    const int lane = F.lane, tid = F.tid, r = lane & 31, hh = lane >> 5, h = 2 * kvh + (F.wave >> 2);
    const int L = s < 16 ? 256 : 1280, row0 = seq_row0(s), q0 = qc * 128 + (F.wave & 3) * 32;
    const bf16* Kb = F.KN + (size_t)kv_row(s, kvh) * 64;
    const bf16* Vb = F.VT + (size_t)kv_row(s, kvh) * 64;
    LAS bf16* lds = (LAS bf16*)F.lds;
    bf16x8 qf[4];
#pragma unroll
    for (int ks = 0; ks < 4; ++ks) qf[ks] = *(const bf16x8*)(F.QN + (size_t)(row0 + q0 + r) * 256 + h * 64 + 16 * ks + 8 * hh);
    f32x16 O0, O1;
#pragma unroll
    for (int e = 0; e < 16; ++e) { O0[e] = 0.f; O1[e] = 0.f; }
    float mrun = -1e30f, lsum = 0.f;
    const int srow = tid >> 3, sch = (tid & 7) * 8;
    u32x4 kreg = *(const u32x4*)(Kb + (size_t)srow * 64 + sch), vreg = *(const u32x4*)(Vb + (size_t)srow * L + sch);
    *(LAS u32x4*)(lds + srow * AT_P + sch) = kreg; *(LAS u32x4*)(lds + AT_TILE + srow * AT_P + sch) = vreg;
    CH_BAR();
    const int nt = L / 64;
#pragma unroll 1
    for (int j = 0; j < nt; ++j) {
        const int jn = j + 1 < nt ? j + 1 : j;
        kreg = *(const u32x4*)(Kb + (size_t)(64 * jn + srow) * 64 + sch); vreg = *(const u32x4*)(Vb + (size_t)srow * L + 64 * jn + sch);
        const LAS bf16* Kt = lds + (j & 1) * 2 * AT_TILE; const LAS bf16* Vt = Kt + AT_TILE;
        attn_tile_lds(Kt, Vt, 0, qf, O0, O1, mrun, lsum, lane);
        attn_tile_lds(Kt, Vt, 1, qf, O0, O1, mrun, lsum, lane);
        LAS bf16* Kn = lds + ((j + 1) & 1) * 2 * AT_TILE;
        *(LAS u32x4*)(Kn + srow * AT_P + sch) = kreg; *(LAS u32x4*)(Kn + AT_TILE + srow * AT_P + sch) = vreg;
        CH_BAR();
    }
    const float ltot = lsum + xor32(lsum, lane), inv = 1.f / ltot;
    bf16* yo = F.Y + (size_t)(row0 + q0 + r) * D + 768 + h * 64;
#pragma unroll
    for (int g4 = 0; g4 < 4; ++g4) {
        const int d = 8 * g4 + 4 * hh;
        st_bf4(yo + d, (f32x4){O0[4 * g4] * inv, O0[4 * g4 + 1] * inv, O0[4 * g4 + 2] * inv, O0[4 * g4 + 3] * inv});
        st_bf4(yo + 32 + d, (f32x4){O1[4 * g4] * inv, O1[4 * g4 + 1] * inv, O1[4 * g4 + 2] * inv, O1[4 * g4 + 3] * inv});
    }
}

constexpr int TP = 72;
constexpr int TSZ = 64 * TP;
enum { SL_A = 0, SL_AT, SL_B, SL_K, SL_R, SL_BT, SL_KT, SL_VT, SL_AAK, SL_ARB, SL_ARK, SL_P, SL_PT, SL_T, SL_S, N_SLOT };
constexpr int CH_F32_OFF = N_SLOT * TSZ * 2;
static_assert(CH_F32_OFF + 1024 + 9 * 256 <= 143360, "chunk LDS map");

template <bool TRANS>
__device__ __forceinline__ void mm_nt(f32x4 (&acc)[2], const LAS bf16* X, const LAS bf16* Y, int R0, int C0, int fr, int fq) {
    bf16x8 xf[2], yf[2][2];
#pragma unroll
    for (int ks = 0; ks < 2; ++ks) xf[ks] = *(const LAS bf16x8*)(X + (R0 + fr) * TP + 32 * ks + 8 * fq);
#pragma unroll
    for (int n = 0; n < 2; ++n)
#pragma unroll
        for (int ks = 0; ks < 2; ++ks) yf[n][ks] = *(const LAS bf16x8*)(Y + (C0 + 16 * n + fr) * TP + 32 * ks + 8 * fq);
#pragma unroll
    for (int n = 0; n < 2; ++n)
#pragma unroll
        for (int ks = 0; ks < 2; ++ks)
            acc[n] = TRANS ? __builtin_amdgcn_mfma_f32_16x16x32_bf16(xf[ks], yf[n][ks], acc[n], 0, 0, 0) : __builtin_amdgcn_mfma_f32_16x16x32_bf16(yf[n][ks], xf[ks], acc[n], 0, 0, 0);
}
__device__ __forceinline__ void st_tile4(LAS bf16* p, f32x4 v) { u32x2 w; w.x = cvtpk(v.x, v.y); w.y = cvtpk(v.z, v.w); *(LAS u32x2*)p = w; }
__device__ __forceinline__ void zero2(f32x4 (&a)[2]) { a[0] = (f32x4){0.f, 0.f, 0.f, 0.f}; a[1] = a[0]; }
__device__ __forceinline__ f32x4 unbf4(u32x2 w) { f32x4 r; r.x = __uint_as_float(w.x << 16); r.y = __uint_as_float(w.x & 0xffff0000u); r.z = __uint_as_float(w.y << 16); r.w = __uint_as_float(w.y & 0xffff0000u); return r; }
__device__ __forceinline__ void tile_transpose(LAS bf16* dst, const LAS bf16* src, const bf16x8 (&idf)[2][2], int R0, int C0, int fr, int fq) {
    bf16x8 xf[2];
#pragma unroll
    for (int ks = 0; ks < 2; ++ks) xf[ks] = *(const LAS bf16x8*)(src + (R0 + fr) * TP + 32 * ks + 8 * fq);
#pragma unroll
    for (int n = 0; n < 2; ++n) {
        f32x4 acc = (f32x4){0.f, 0.f, 0.f, 0.f};
#pragma unroll
        for (int ks = 0; ks < 2; ++ks) acc = __builtin_amdgcn_mfma_f32_16x16x32_bf16(xf[ks], idf[n][ks], acc, 0, 0, 0);
        st_tile4(dst + (C0 + 16 * n + fr) * TP + R0 + 4 * fq, acc);
    }
}
__device__ __forceinline__ void make_identity_frags(bf16x8 (&idf)[2][2], int C0, int fr, int fq) {
#pragma unroll
    for (int n = 0; n < 2; ++n)
#pragma unroll
        for (int ks = 0; ks < 2; ++ks) {
            const int d = (C0 + 16 * n + fr) - (32 * ks + 8 * fq);
            u32x4 iw = (u32x4){0u, 0u, 0u, 0u};
            const unsigned one = (d & 1) ? 0x3f800000u : 0x00003f80u;
            if (d >= 0 && d < 8) { if ((d >> 1) == 0) iw.x = one; else if ((d >> 1) == 1) iw.y = one; else if ((d >> 1) == 2) iw.z = one; else iw.w = one; }
            idf[n][ks] = __builtin_bit_cast(bf16x8, iw);
        }
}
__device__ __forceinline__ void st_bf4_fast(bf16* p, f32x4 v) { u32x2 w; w.x = cvtpk(v.x, v.y); w.y = cvtpk(v.z, v.w); *(u32x2*)p = w; }

template <int MIX> struct RawRow;
template <> struct RawRow<0> { u32x2 r[3], k[3], v[3], E, a; };
template <> struct RawRow<1> { u32x2 x[3][3]; float bd, ad; };
template <> struct RawRow<2> { u32x2 q, k, v, ad[4]; };
__device__ __forceinline__ u32x2 ldraw(const bf16* p, bool ok) { return ok ? *(const u32x2*)p : (u32x2){0u, 0u}; }
__device__ __forceinline__ void load_raw(RawRow<0>& w, Frame& F, int dir, int h, int row, bool hasp, bool hasn, int sq) {
    const int c = h * 64 + 4 * sq; const bf16* p = F.P + (size_t)row * NP + PA + c;
    w.r[0] = ldraw(p - NP, hasp); w.r[1] = ldraw(p, true); w.r[2] = ldraw(p + NP, hasn);
    w.k[0] = ldraw(p + 256 - NP, hasp); w.k[1] = ldraw(p + 256, true); w.k[2] = ldraw(p + 256 + NP, hasn);
    w.v[0] = ldraw(p + 512 - NP, hasp); w.v[1] = ldraw(p + 512, true); w.v[2] = ldraw(p + 512 + NP, hasn);
    w.E = *(const u32x2*)(F.FEAT + (size_t)row * NFEAT + dir * 256 + c); w.a = *(const u32x2*)(F.FEAT + (size_t)row * NFEAT + 512 + dir * 256 + c);
}
__device__ __forceinline__ void load_raw(RawRow<1>& w, Frame& F, int dir, int h, int row, bool hasp, bool hasn, int sq) {
    const int c = h * 64 + 4 * sq; const bf16* p = F.P + (size_t)row * NP + PC + c;
#pragma unroll
    for (int part = 0; part < 3; ++part) { w.x[part][0] = ldraw(p + 256 * part - NP, hasp); w.x[part][1] = ldraw(p + 256 * part, true); w.x[part][2] = ldraw(p + 256 * part + NP, hasn); }
    w.bd = bf2f(F.P[(size_t)row * NP + PC + 1024 + dir * 4 + h]); w.ad = bf2f(F.P[(size_t)row * NP + PC + 1032 + dir * 4 + h]);
}
__device__ __forceinline__ void load_raw(RawRow<2>& w, Frame& F, int dir, int h, int row, bool hasp, bool hasn, int sq) {
    const bf16* p = F.P + (size_t)row * NP + PB;
    const int kx = (sq < 8) ? 4 * sq : 0;
    w.q = *(const u32x2*)(p + h * 32 + kx); w.k = *(const u32x2*)(p + 128 + h * 32 + kx); w.v = *(const u32x2*)(p + 256 + h * 64 + 4 * sq);
#pragma unroll
    for (int j = 0; j < 4; ++j) w.ad[j] = *(const u32x2*)(p + 512 + dir * 16 + 4 * j);
}

template <int MIX  >
__device__ __forceinline__ void chunk_item(Frame& F, int l, int s, int dir, int h) {
    LAS bf16* tl = (LAS bf16*)F.lds;
#define SLOT(x) (tl + (x) * TSZ)
    LAS float* fa = (LAS float*)(F.lds + CH_F32_OFF);
    LAS float* LGE = (LAS float*)(F.lds + SL_AAK * TSZ * 2);
    LAS float* TOT = LGE + 4096;
    LAS float* AD = (LAS float*)(F.lds + SL_T * TSZ * 2);
    LAS float* AS = AD + 1024; LAS float* MS = AD + 1536;
    LAS float* TD = (LAS float*)(F.lds + SL_K * TSZ * 2);
    LAS bf16* M2T = (LAS bf16*)(TD + 1024);
    const int T = s < 16 ? 256 : 1024, row0 = seq_row0(s), nch = T / 64, tid = F.tid, lane = F.lane, wv = F.wave;
    const int fr = lane & 15, fq = lane >> 4, R0 = 16 * (wv >> 1), C0 = 32 * (wv & 1);
    const int stok = tid >> 4, sq = tid & 15;
    f32x4 sacc[2]; zero2(sacc);
    if (s >= 16) {
        const int b = s - 16;
#pragma unroll
        for (int n = 0; n < 2; ++n) {
            const int v = R0 + fr, k = C0 + 16 * n + 4 * fq;
            if (MIX == 0) sacc[n] = *(const f32x4*)(F.in[I_SR] + ((((size_t)(b * 2 + l) * 2 + dir) * 4 + h) * 64 + v) * 64 + k);
            else if (MIX == 1) { const float* sp = F.in[I_SD] + (((size_t)(b * 2 + l) * 2 + dir) * 4 + h) * 64 * 64 + v;
#pragma unroll
                for (int e = 0; e < 4; ++e) sacc[n][e] = sp[(size_t)(k + e) * 64]; }
            else if (k < 32) { const float* sp = F.in[I_SG] + (((size_t)(b * 2 + l) * 2 + dir) * 4 + h) * 32 * 64 + v;
#pragma unroll
                for (int e = 0; e < 4; ++e) sacc[n][e] = sp[(size_t)(k + e) * 64]; }
        }
    }
    LAS float* PRM = fa + 256;
    if (MIX == 0 && tid < 320) { const int q = tid >> 6, k = tid & 63, c = h * 64 + k;
        PRM[q * 64 + k] = (q < 3) ? F.in[I_MU][l * 1184 + PA + 256 * q + c] : ((q == 3) ? F.in[I_KK][l * 256 + c] : F.in[I_KA][l * 256 + c]); }
    if (MIX == 1) { for (int idx = tid; idx < 576; idx += 512) { const int q = idx >> 6, k = idx & 63, part = q / 3, tap = q % 3; PRM[q * 64 + k] = F.in[I_DCV][l * 3 * 768 + tap * 768 + part * 256 + h * 64 + k]; } }
    float dl_a = 0.f, dl_dt = 0.f;
    if (MIX == 1) { dl_a = -__expf(F.in[I_DAL][(l * 2 + dir) * 4 + h]); dl_dt = F.in[I_DDT][(l * 2 + dir) * 4 + h]; }
    RawRow<MIX> raw[2];
#pragma unroll
    for (int rr = 0; rr < 2; ++rr) { const int i = stok + 32 * rr, tb0 = dir == 0 ? 0 : T - 64, t = tb0 + (dir == 0 ? i : 63 - i); load_raw(raw[rr], F, dir, h, row0 + t, t > 0, t < T - 1, sq); }
    bf16x8 idf[2][2]; make_identity_frags(idf, C0, lane & 15, lane >> 4);
    CH_BAR();
#pragma unroll 1
    for (int ci = 0; ci < nch; ++ci) {
        const int tb = dir == 0 ? 64 * ci : T - 64 * (ci + 1);
        int lane_ = F.lane; asm volatile("" : "+v"(lane_));
        const int tid = F.wave * 64 + lane_, lane = lane_, fr = lane_ & 15, fq = lane_ >> 4, stok = tid >> 4, sq = tid & 15;
        f32x4 pA[2], pB[2], pK[2], pR[2], pE[2];
        f32x4 prm[9];
        if (MIX == 0) {
#pragma unroll
            for (int q = 0; q < 5; ++q) prm[q] = *(const LAS f32x4*)(PRM + q * 64 + 4 * sq); }
        if (MIX == 1) {
#pragma unroll
            for (int q = 0; q < 9; ++q) prm[q] = *(const LAS f32x4*)(PRM + q * 64 + 4 * sq); }
        float bt[2] = {0.f, 0.f};
#pragma unroll
        for (int rr = 0; rr < 2; ++rr) {
            const int i = stok + 32 * rr;
            if constexpr (MIX == 0) {
                const RawRow<0>& w = raw[rr];
                const f32x4 rc = unbf4(w.r[1]), kc = unbf4(w.k[1]), vc = unbf4(w.v[1]);
                const f32x4 r4 = rc + prm[0] * ((unbf4(w.r[0]) + unbf4(w.r[2])) * 0.5f - rc), k4 = kc + prm[1] * ((unbf4(w.k[0]) + unbf4(w.k[2])) * 0.5f - kc), v4 = vc + prm[2] * ((unbf4(w.v[0]) + unbf4(w.v[2])) * 0.5f - vc);
                const f32x4 E4 = unbf4(w.E), a4 = unbf4(w.a);
                f32x4 kk4 = k4 * prm[3];
                kk4 = kk4 * rsqrtf(row16_sum(sum4q(kk4)) + 1e-6f);
                pA[rr] = kk4; pB[rr] = kk4 * a4; pK[rr] = k4 * ((a4 - 1.f) * prm[4] + 1.f); pR[rr] = r4; pE[rr] = E4;
                *(LAS f32x4*)(LGE + i * 64 + 4 * sq) = E4; st_tile4(SLOT(SL_ARK) + i * TP + 4 * sq, v4);
            } else if constexpr (MIX == 2) {
                const RawRow<2>& w = raw[rr];
                f32x4 q4 = (f32x4){0.f, 0.f, 0.f, 0.f}, k4 = q4, E4 = q4;
                if (sq < 8) {
                    const int kx = 4 * sq;
                    q4 = unbf4(w.q) * 0.17677669529f; k4 = unbf4(w.k);
                    const float* au = F.in[I_GAU] + (size_t)(l * 2 + dir) * 16 * 128 + h * 32 + kx;
                    f32x4 x4 = *(const f32x4*)(F.in[I_GAB] + (l * 2 + dir) * 128 + h * 32 + kx);
#pragma unroll
                    for (int jj = 0; jj < 4; ++jj) { const f32x4 ad = unbf4(w.ad[jj]);
#pragma unroll
                        for (int j = 0; j < 4; ++j) x4 += *(const f32x4*)(au + (4 * jj + j) * 128) * ad[j]; }
                    E4 = (f32x4){softplusf(-x4.x), softplusf(-x4.y), softplusf(-x4.z), softplusf(-x4.w)} * (1.f / 16.f);
                }
                pK[rr] = k4; pR[rr] = q4; pE[rr] = E4;
                *(LAS f32x4*)(LGE + i * 64 + 4 * sq) = E4;
                st_tile4(SLOT(SL_ARK) + i * TP + 4 * sq, unbf4(w.v));
            } else {
                const RawRow<1>& w = raw[rr];
                f32x4 o3[3];
#pragma unroll
                for (int part = 0; part < 3; ++part) {
                    const f32x4 y = unbf4(w.x[part][0]) * prm[part * 3 + 0] + unbf4(w.x[part][1]) * prm[part * 3 + 1] + unbf4(w.x[part][2]) * prm[part * 3 + 2];
                    o3[part] = (f32x4){siluf(y.x), siluf(y.y), siluf(y.z), siluf(y.w)};
                }
                pA[rr] = o3[0] * (rsqrtf(row16_sum(sum4q(o3[0])) + 1e-6f) * 0.125f);
                pK[rr] = o3[1] * rsqrtf(row16_sum(sum4q(o3[1])) + 1e-6f);
                pR[rr] = o3[2];
                bt[rr] = sigm(w.bd);
                if (sq == 0) { fa[192 + i] = dl_a * softplusf(w.ad + dl_dt); fa[128 + i] = bt[rr]; }
            }
        }
        CH_BAR();
        if (MIX != 1) {
            const int k = tid & 63, tg = tid >> 6; float ev[8];
#pragma unroll
            for (int j = 0; j < 8; ++j) ev[j] = LGE[(8 * tg + j) * 64 + k];
            float p = 0.f;
#pragma unroll
            for (int j = 0; j < 8; ++j) { p += ev[j]; LGE[(8 * tg + j) * 64 + k] = p; }
            TOT[tg * 64 + k] = p;
        } else if (tid < 64) {
            float acc = 0.f;
            for (int j = 0; j < 64; ++j) { const float g = fa[192 + j]; acc += (j <= tid) ? g : 0.f; }
            fa[64 + tid] = acc;
        }
#pragma unroll
        for (int n = 0; n < 2; ++n) st_tile4(SLOT(SL_S) + (R0 + fr) * TP + C0 + 16 * n + 4 * fq, sacc[n]);
        CH_BAR();
        float gC_delta = 0.f;
        if (MIX != 1) {
            f32x4 tot4 = (f32x4){0.f, 0.f, 0.f, 0.f}, pre[2];
#pragma unroll
            for (int g = 0; g < 8; ++g) { const f32x4 tg4 = *(const LAS f32x4*)(TOT + g * 64 + 4 * sq); if (g == (stok >> 3)) pre[0] = tot4; if (g == 4 + (stok >> 3)) pre[1] = tot4; tot4 += tg4; }
            if (stok == 0) *(LAS f32x4*)(fa + 4 * sq) = (f32x4){__expf(-tot4.x), __expf(-tot4.y), __expf(-tot4.z), __expf(-tot4.w)};
#pragma unroll
            for (int rr = 0; rr < 2; ++rr) {
                const int i = stok + 32 * rr;
                const f32x4 lg = *(const LAS f32x4*)(LGE + i * 64 + 4 * sq) + pre[rr];
                f32x4 einv, eg, ec, ep;
#pragma unroll
                for (int e = 0; e < 4; ++e) { einv[e] = __expf(lg[e]); eg[e] = __expf(-lg[e]); ec[e] = __expf(lg[e] - tot4[e]); ep[e] = __expf(pE[rr][e] - lg[e]); }
                const f32x4 Rt = pR[rr] * eg, Kh = pK[rr] * einv, Kb = pK[rr] * ec;
                st_tile4(SLOT(SL_R) + i * TP + 4 * sq, Rt); st_tile4(SLOT(SL_K) + i * TP + 4 * sq, Kh);
                st_tile4(SLOT(SL_PT) + i * TP + 4 * sq, Kb);
                if (MIX == 0) {
                    const f32x4 At = pA[rr] * ep * -1.f, Bh = pB[rr] * einv, Bb = pB[rr] * ec;
                    st_tile4(SLOT(SL_A) + i * TP + 4 * sq, At); st_tile4(SLOT(SL_B) + i * TP + 4 * sq, Bh); st_tile4(SLOT(SL_P) + i * TP + 4 * sq, Bb);
                }
            }
        } else {
            const float gcC = fa[64 + 63]; gC_delta = __expf(gcC);
#pragma unroll
            for (int rr = 0; rr < 2; ++rr) {
                const int i = stok + 32 * rr; const float gci = fa[64 + i], eg = __expf(gci), ec = __expf(gcC - gci);
                st_tile4(SLOT(SL_A) + i * TP + 4 * sq, pA[rr]);
                st_tile4(SLOT(SL_K) + i * TP + 4 * sq, pK[rr]);
                st_tile4(SLOT(SL_R) + i * TP + 4 * sq, pA[rr] * eg);
                const f32x4 At = pK[rr] * (-bt[rr] * eg), Bb = pK[rr] * ec, bv = pR[rr] * bt[rr];
                st_tile4(SLOT(SL_T) + i * TP + 4 * sq, At); st_tile4(SLOT(SL_P) + i * TP + 4 * sq, Bb); st_tile4(SLOT(SL_ARK) + i * TP + 4 * sq, bv);
            }
        }
        if (ci + 1 < nch) {
            const int tbn = dir == 0 ? 64 * (ci + 1) : T - 64 * (ci + 2);
#pragma unroll
            for (int rr = 0; rr < 2; ++rr) { const int i = stok + 32 * rr, t = tbn + (dir == 0 ? i : 63 - i); load_raw(raw[rr], F, dir, h, row0 + t, t > 0, t < T - 1, sq); }
        }
        CH_BAR();
        tile_transpose(SLOT(SL_VT), SLOT(SL_ARK), idf, R0, C0, fr, fq);
        if (MIX != 1) tile_transpose(SLOT(SL_KT), SLOT(SL_PT), idf, R0, C0, fr, fq);
        if (MIX != 2) tile_transpose(SLOT(SL_BT), SLOT(SL_P), idf, R0, C0, fr, fq);
        if (MIX == 0) tile_transpose(SLOT(SL_AT), SLOT(SL_A), idf, R0, C0, fr, fq);
        if (MIX == 1) tile_transpose(SLOT(SL_AT), SLOT(SL_T), idf, R0, C0, fr, fq);
        CH_BAR();
        if (MIX != 2) {
            { LAS u32x2* zp = (LAS u32x2*)(SLOT(SL_PT) + (tid >> 3) * TP + (tid & 7) * 8); zp[0] = (u32x2){0u, 0u}; zp[1] = (u32x2){0u, 0u}; }
            f32x4 a1[2], a3[2]; zero2(a1); zero2(a3);
            if (MIX == 0) { mm_nt<false>(a1, SLOT(SL_A), SLOT(SL_B), R0, C0, fr, fq); mm_nt<false>(a3, SLOT(SL_R), SLOT(SL_B), R0, C0, fr, fq); }
            else { mm_nt<false>(a1, SLOT(SL_K), SLOT(SL_K), R0, C0, fr, fq); mm_nt<false>(a3, SLOT(SL_A), SLOT(SL_K), R0, C0, fr, fq); }
#pragma unroll
            for (int n = 0; n < 2; ++n) {
                const int r = R0 + fr, c0 = C0 + 16 * n + 4 * fq;
                f32x4 av, rb;
#pragma unroll
                for (int e = 0; e < 4; ++e) {
                    const int c = c0 + e; float x = a1[n][e], y = a3[n][e];
                    if (MIX == 1) { const float dc = __expf(fa[64 + r] - fa[64 + c]); x = -fa[128 + r] * dc * x; y = dc * y; }
                    av[e] = (c < r) ? x : 0.f; rb[e] = (c <= r) ? y : 0.f;
                }
                st_tile4(SLOT(SL_P) + r * TP + c0, av); st_tile4(SLOT(SL_ARB) + r * TP + c0, rb);
                const int br = wv >> 1, bc = 2 * (wv & 1) + n;
                if (br == bc) *(LAS f32x4*)(AD + br * 256 + fr * 16 + 4 * fq) = av;
                if (br == bc + 1 && (bc & 1) == 0) *(LAS f32x4*)(AS + (bc >> 1) * 256 + fr * 16 + 4 * fq) = av;
            }
        }
        if (MIX != 1) {
            f32x4 a4[2]; zero2(a4); mm_nt<false>(a4, SLOT(SL_R), SLOT(SL_K), R0, C0, fr, fq);
            f32x4 a2[2]; zero2(a2); if (MIX == 0) mm_nt<false>(a2, SLOT(SL_A), SLOT(SL_K), R0, C0, fr, fq);
#pragma unroll
            for (int n = 0; n < 2; ++n) {
                const int r = R0 + fr, c0 = C0 + 16 * n + 4 * fq; f32x4 rk, ak;
#pragma unroll
                for (int e = 0; e < 4; ++e) { rk[e] = (c0 + e <= r) ? a4[n][e] : 0.f; ak[e] = (c0 + e < r) ? a2[n][e] : 0.f; }
                st_tile4(SLOT(SL_ARK) + r * TP + c0, rk);
                if (MIX == 0) st_tile4(SLOT(SL_AAK) + r * TP + c0, ak);
            }
        }
        CH_BAR();
        f32x4 zacc[2]; zero2(zacc);
        if (MIX != 2) {
            if (MIX == 0) { f32x4 u[2]; zero2(u); mm_nt<false>(u, SLOT(SL_VT), SLOT(SL_AAK), R0, C0, fr, fq);
#pragma unroll
                for (int n = 0; n < 2; ++n) st_tile4(SLOT(SL_A) + (R0 + fr) * TP + C0 + 16 * n + 4 * fq, u[n]); }
            if (wv == 0) {
                int b = lane >> 4, c = lane & 15; asm volatile("" : "+v"(b), "+v"(c)); float tcol[16];
                tcol[0] = (c == 0) ? 1.f : 0.f;
                f32x4 cur[4], nxt[4];
#pragma unroll
                for (int j4 = 0; j4 < 4; ++j4) { cur[j4] = (f32x4){0.f, 0.f, 0.f, 0.f}; nxt[j4] = cur[j4]; }
                cur[0] = *(const LAS f32x4*)(AD + b * 256 + 16);
#pragma unroll
                for (int r = 1; r < 16; ++r) {
                    if (r + 1 < 16) {
#pragma unroll
                        for (int j4 = 0; j4 < (r + 4) / 4; ++j4) nxt[j4] = *(const LAS f32x4*)(AD + b * 256 + (r + 1) * 16 + 4 * j4);
                    }
                    float acc = (r == c) ? 1.f : 0.f;
#pragma unroll
                    for (int j = 0; j < r; ++j) acc += cur[j >> 2][j & 3] * tcol[j];
                    tcol[r] = acc;
#pragma unroll
                    for (int j4 = 0; j4 < 4; ++j4) cur[j4] = nxt[j4];
                    __builtin_amdgcn_sched_barrier(0);
                }
#pragma unroll
                for (int r = 0; r < 16; ++r) { TD[b * 256 + r * 16 + c] = tcol[r]; SLOT(SL_PT)[(16 * b + r) * TP + 16 * b + c] = (bf16)f2bf(tcol[r]); }
                u32x4 w0, w1;
                w0.x = cvtpk(tcol[0], tcol[1]); w0.y = cvtpk(tcol[2], tcol[3]); w0.z = cvtpk(tcol[4], tcol[5]); w0.w = cvtpk(tcol[6], tcol[7]);
                w1.x = cvtpk(tcol[8], tcol[9]); w1.y = cvtpk(tcol[10], tcol[11]); w1.z = cvtpk(tcol[12], tcol[13]); w1.w = cvtpk(tcol[14], tcol[15]);
                *(LAS u32x4*)(SLOT(SL_B) + (16 * b + c) * TP + 16 * b) = w0; *(LAS u32x4*)(SLOT(SL_B) + (16 * b + c) * TP + 16 * b + 8) = w1;
            } else if (wv == 1) {
                LAS u32x2* zp = (LAS u32x2*)(SLOT(SL_B) + (16 + (lane >> 2)) * TP + (lane & 3) * 4); zp[0] = (u32x2){0u, 0u};
            }
            CH_BAR();
            {
                const int which = tid >> 8, r = (tid >> 4) & 15, c = tid & 15, bA = 2 * which + 1, bT = 2 * which;
                float m = 0.f;
#pragma unroll
                for (int j = 0; j < 16; ++j) m += AS[which * 256 + r * 16 + j] * TD[bT * 256 + j * 16 + c];
                MS[which * 256 + r * 16 + c] = m;
                CH_BAR();
                float v = 0.f;
#pragma unroll
                for (int j = 0; j < 16; ++j) v += TD[bA * 256 + r * 16 + j] * MS[which * 256 + j * 16 + c];
                SLOT(SL_PT)[(16 * bA + r) * TP + 16 * bT + c] = (bf16)f2bf(v);
                SLOT(SL_B)[(16 * bT + c) * TP + 16 * bA + r] = (bf16)f2bf(v);
            }
            CH_BAR();
            if (wv < 4) {
                const int a = wv >> 1, bq = wv & 1;
                const bf16x8 xf = *(const LAS bf16x8*)(SLOT(SL_P) + (32 + 16 * a + fr) * TP + 8 * fq), yf = *(const LAS bf16x8*)(SLOT(SL_B) + (16 * bq + fr) * TP + 8 * fq);
                f32x4 m2 = (f32x4){0.f, 0.f, 0.f, 0.f};
                m2 = __builtin_amdgcn_mfma_f32_16x16x32_bf16(xf, yf, m2, 0, 0, 0);
                st_tile4(M2T + (16 * bq + fr) * TP + 16 * a + 4 * fq, m2);
            }
            CH_BAR();
            if (wv < 4) {
                const int a = wv >> 1, bq = wv & 1;
                const bf16x8 xf = *(const LAS bf16x8*)(SLOT(SL_PT) + (32 + 16 * a + fr) * TP + 32 + 8 * fq), yf = *(const LAS bf16x8*)(M2T + (16 * bq + fr) * TP + 8 * fq);
                f32x4 tb4 = (f32x4){0.f, 0.f, 0.f, 0.f};
                tb4 = __builtin_amdgcn_mfma_f32_16x16x32_bf16(yf, xf, tb4, 0, 0, 0);
                st_tile4(SLOT(SL_PT) + (32 + 16 * a + fr) * TP + 16 * bq + 4 * fq, tb4);
            }
            CH_BAR();
            {
                f32x4 w1[2]; zero2(w1); mm_nt<false>(w1, SLOT(SL_PT), SLOT(SL_AT), R0, C0, fr, fq);
#pragma unroll
                for (int n = 0; n < 2; ++n) st_tile4(SLOT(SL_P) + (R0 + fr) * TP + C0 + 16 * n + 4 * fq, w1[n]);
                mm_nt<false>(zacc, SLOT(MIX == 0 ? SL_A : SL_VT), SLOT(SL_PT), R0, C0, fr, fq);
            }
            CH_BAR();
            mm_nt<false>(zacc, SLOT(SL_S), SLOT(SL_P), R0, C0, fr, fq);
#pragma unroll
            for (int n = 0; n < 2; ++n) st_tile4(SLOT(SL_PT) + (R0 + fr) * TP + C0 + 16 * n + 4 * fq, zacc[n]);
            CH_BAR();
        }
        {
            f32x4 y[2]; zero2(y);
            mm_nt<false>(y, SLOT(SL_R), SLOT(SL_S), R0, C0, fr, fq);
            if (MIX != 2) mm_nt<false>(y, SLOT(SL_ARB), SLOT(SL_PT), R0, C0, fr, fq);
            if (MIX != 1) mm_nt<false>(y, SLOT(SL_ARK), SLOT(SL_VT), R0, C0, fr, fq);
            const int i = R0 + fr, t = tb + (dir == 0 ? i : 63 - i);
            bf16* yo = F.YP + ((size_t)(MIX * 2 + dir) * M + row0 + t) * 256 + h * 64 + C0 + 4 * fq;
            st_bf4_fast(yo, y[0]); st_bf4_fast(yo + 16, y[1]);
#pragma unroll
            for (int n = 0; n < 2; ++n) {
                if (MIX == 1) sacc[n] = sacc[n] * gC_delta; else sacc[n] = sacc[n] * *(const LAS f32x4*)(fa + C0 + 16 * n + 4 * fq);
            }
            if (MIX != 2) mm_nt<false>(sacc, SLOT(SL_PT), SLOT(SL_BT), R0, C0, fr, fq);
            if (MIX != 1) mm_nt<false>(sacc, SLOT(SL_VT), SLOT(SL_KT), R0, C0, fr, fq);
        }
        CH_BAR();
    }
    if (s < 16) {
#pragma unroll
        for (int n = 0; n < 2; ++n) {
            const int v = R0 + fr, k = C0 + 16 * n + 4 * fq;
            if (MIX == 0) *(f32x4*)(F.out + O_SR + ((((size_t)(s * 2 + l) * 2 + dir) * 4 + h) * 64 + v) * 64 + k) = sacc[n];
            else if (MIX == 1) { float* sp = F.out + O_SD + (((size_t)(s * 2 + l) * 2 + dir) * 4 + h) * 64 * 64 + v;
#pragma unroll
                for (int e = 0; e < 4; ++e) sp[(size_t)(k + e) * 64] = sacc[n][e]; }
            else if (k < 32) { float* sp = F.out + O_SG + (((size_t)(s * 2 + l) * 2 + dir) * 4 + h) * 32 * 64 + v;
#pragma unroll
                for (int e = 0; e < 4; ++e) sp[(size_t)(k + e) * 64] = sacc[n][e]; }
        }
    }
#undef SLOT
}

constexpr int Q_LAT = 192, Q_CTX = 384, Q_ATL = 128, Q_ATC = 64, Q_MIX = Q_LAT + Q_CTX + Q_ATL + Q_ATC;
constexpr int Q_CONV = (16 * 176 + 44 * 32) / 8, Q_TOTAL = Q_MIX + Q_CONV;
#define MKFRAME() Frame F; { kptr_t kp = (kptr_t)__builtin_amdgcn_kernarg_segment_ptr(); asm volatile("" : "+s"(kp)); \
    F.lds = (LAS unsigned char*)lds_raw; F.in = (inptr_t)kp; F.out = *(float* const __attribute__((address_space(4)))*)(kp + 8 * N_INPUTS); F.ws = *(unsigned char* const __attribute__((address_space(4)))*)(kp + 8 * N_INPUTS + 8); \
    { int l_; asm volatile("v_mbcnt_lo_u32_b32 %0, -1, 0\n\tv_mbcnt_hi_u32_b32 %0, -1, %0" : "=v"(l_)); int w_ = wave0, g_ = gridDim.x, b_ = blockIdx.x; asm volatile("" : "+s"(w_), "+s"(g_), "+s"(b_)); F.G = g_; F.bid = b_; F.lane = l_; F.wave = w_; F.tid = w_ * 64 + l_; } \
    F.X = F.out + O_Y; F.MOD = (float*)(F.ws + WS_MOD); \
    F.W1 = (bf16*)(F.ws + WS_W1); F.W2 = (bf16*)(F.ws + WS_W2); F.WIN = (bf16*)(F.ws + WS_WIN); F.WB = (bf16*)(F.ws + WS_WB); F.WO = (bf16*)(F.ws + WS_WO); \
    F.XN = (bf16*)(F.ws + WS_XN); F.Y = (bf16*)(F.ws + WS_Y); F.P = (bf16*)(F.ws + WS_P); F.H = (bf16*)(F.ws + WS_FEAT); \
    F.FEAT = (bf16*)(F.ws + WS_FEAT); F.YP = (bf16*)(F.ws + WS_YP); F.QN = (bf16*)(F.ws + WS_QN); F.KN = (bf16*)(F.ws + WS_KN); F.VT = (bf16*)(F.ws + WS_VT); \
    F.MG = (float*)(F.ws + WS_MG); F.ctl = (unsigned*)(F.ws + WS_CTL); }
__device__ __forceinline__ void scan_phase(Frame& F0, int l, int qi) {
    LAS unsigned char* lds_raw = F0.lds; const int wave0 = F0.wave;
    volatile LAS unsigned* misc = (volatile LAS unsigned*)(lds_raw + MISC_OFF);
    for (;;) {
        __syncthreads();
        MKFRAME();
        if (F.tid == 0) misc[0] = __hip_atomic_fetch_add(F.ctl + CW_Q + 64 * qi, 1u, __ATOMIC_RELAXED, __HIP_MEMORY_SCOPE_AGENT);
        __syncthreads();
        unsigned mo_ = MISC_OFF; asm volatile("" : "+v"(mo_));
        const int item = (int)*(volatile LAS unsigned*)(lds_raw + mo_);
        if (item >= Q_MIX) break;
        if (item < Q_LAT + Q_CTX) {
            int mix, s, rem;
            if (item < Q_LAT) { mix = item >> 6; rem = item & 63; s = 16 + (rem >> 3); }
            else { const int i2 = item - Q_LAT; mix = i2 >> 7; rem = i2 & 127; s = rem >> 3; }
            const int dir = (rem >> 2) & 1, h = rem & 3;
#ifndef CH_MASK
#define CH_MASK 7
#endif
            if (mix == 0) { if (CH_MASK & 1) chunk_item<0>(F, l, s, dir, h); else scan_item<0>(F, l, s, dir, h); }
            else if (mix == 1) { if (CH_MASK & 2) chunk_item<1>(F, l, s, dir, h); else scan_item<1>(F, l, s, dir, h); }
            else { if (CH_MASK & 4) chunk_item<2>(F, l, s, dir, h); else scan_item<2>(F, l, s, dir, h); }
        } else if (item < Q_LAT + Q_CTX + Q_ATL) {
            const int i2 = item - (Q_LAT + Q_CTX); attn_item(F, 16 + (i2 >> 4), (i2 >> 3) & 1, i2 & 7);
        } else if (item < Q_MIX) {
            const int i2 = item - (Q_LAT + Q_CTX + Q_ATL); attn_item(F, i2 >> 2, (i2 >> 1) & 1, i2 & 1);
        }
    }
}

__device__ __forceinline__ float sum4(f32x4 v) { return (v.x + v.y) + (v.z + v.w); }
__device__ __forceinline__ void post_phase(Frame& F, int l) {
    const int gw = F.bid * 8 + F.wave, NGW = F.G * 8, lane = F.lane;
    const float* mu = F.in[I_MU] + l * 1184;
    const int c = (lane >> 4) * 64 + (lane & 15) * 4, ch = (lane & 15) * 4;
    const f32x4 lng = *(const f32x4*)(F.in[I_LNG] + l * 256 + c), lnb = *(const f32x4*)(F.in[I_LNB] + l * 256 + c), kaw = *(const f32x4*)(F.in[I_KA] + l * 256 + c), rkw = *(const f32x4*)(F.in[I_RK] + l * 256 + c);
    const f32x4 gng = *(const f32x4*)(F.in[I_GNG] + l * 64 + ch), dng = *(const f32x4*)(F.in[I_DNG] + l * 64 + ch);
    const f32x4 mu_r = *(const f32x4*)(mu + PA + c), mu_k = *(const f32x4*)(mu + PA + 256 + c), mu_v = *(const f32x4*)(mu + PA + 512 + c);
    for (int rowb = 2 * gw; rowb < M; rowb += 2 * NGW) {
        u32x2 wy[2][6], wr[2][3], wk[2][3], wvv[2][3], wf[2][3], wg[2][2]; bool ok[2];
#pragma unroll
        for (int q = 0; q < 2; ++q) {
            const int row = rowb + q; ok[q] = row < M;
            if (ok[q]) {
                int s, t, T; row_geom(row, s, t, T); const bool hasp = t > 0, hasn = t < T - 1;
#pragma unroll
                for (int j = 0; j < 6; ++j) wy[q][j] = *(const u32x2*)(F.YP + ((size_t)j * M + row) * 256 + c);
                const bf16* p = F.P + (size_t)row * NP + PA + c; const u32x2 z = (u32x2){0u, 0u};
                wr[q][1] = *(const u32x2*)p; wk[q][1] = *(const u32x2*)(p + 256); wvv[q][1] = *(const u32x2*)(p + 512);
                if (q == 0) { wr[0][0] = hasp ? *(const u32x2*)(p - NP) : z; wk[0][0] = hasp ? *(const u32x2*)(p + 256 - NP) : z; wvv[0][0] = hasp ? *(const u32x2*)(p + 512 - NP) : z; }
                else { wr[1][2] = hasn ? *(const u32x2*)(p + NP) : z; wk[1][2] = hasn ? *(const u32x2*)(p + 256 + NP) : z; wvv[1][2] = hasn ? *(const u32x2*)(p + 512 + NP) : z; }
#pragma unroll
                for (int j = 0; j < 3; ++j) wf[q][j] = *(const u32x2*)(F.FEAT + (size_t)row * NFEAT + 512 + 256 * j + c);
                wg[q][0] = *(const u32x2*)(F.P + (size_t)row * NP + PB + 544 + c); wg[q][1] = *(const u32x2*)(F.P + (size_t)row * NP + PC + 768 + c);
            }
        }
        wr[0][2] = wr[1][1]; wk[0][2] = wk[1][1]; wvv[0][2] = wvv[1][1]; wr[1][0] = wr[0][1]; wk[1][0] = wk[0][1]; wvv[1][0] = wvv[0][1];
#pragma unroll
        for (int q = 0; q < 2; ++q) {
            if (!ok[q]) continue;
            const int row = rowb + q;
            {
                const f32x4 y = unbf4_(wy[q][0]) + unbf4_(wy[q][1]);
                const float mean = row16_sum(sum4(y)) * (1.f / 64.f); const f32x4 dv = y - mean;
                const float var = row16_sum(sum4(dv * dv)) * (1.f / 64.f);
                const f32x4 yn = dv * rsqrtf(var + 64e-5f) * lng + lnb;
                const f32x4 rc = unbf4_(wr[q][1]), kc = unbf4_(wk[q][1]), vc = unbf4_(wvv[q][1]);
                const f32x4 r4 = rc + mu_r * ((unbf4_(wr[q][0]) + unbf4_(wr[q][2])) * 0.5f - rc), k4 = kc + mu_k * ((unbf4_(wk[q][0]) + unbf4_(wk[q][2])) * 0.5f - kc), v4 = vc + mu_v * ((unbf4_(wvv[q][0]) + unbf4_(wvv[q][2])) * 0.5f - vc);
                const f32x4 af = unbf4_(wf[q][0]), ab = unbf4_(wf[q][1]), gg = unbf4_(wf[q][2]);
                const f32x4 kds = k4 * ((af + ab - 2.f) * kaw + 2.f);
                const float bs = row16_sum(sum4(r4 * kds * rkw));
                st_bf4(F.Y + (size_t)row * D + c, (yn + v4 * bs) * gg);
            }
            {
                const f32x4 o = unbf4_(wy[q][4]) + unbf4_(wy[q][5]);
                const float ms = row16_sum(sum4(o * o)) * (1.f / 64.f);
                const f32x4 rg = unbf4_(wg[q][0]);
                f32x4 sg; sg.x = siluf(rg.x); sg.y = siluf(rg.y); sg.z = siluf(rg.z); sg.w = siluf(rg.w);
                st_bf4(F.Y + (size_t)row * D + 256 + c, o * rsqrtf(ms + 1e-6f) * gng * sg);
            }
            {
                const f32x4 o = unbf4_(wy[q][2]) + unbf4_(wy[q][3]);
                const float ms = row16_sum(sum4(o * o)) * (1.f / 64.f);
                const f32x4 gt = unbf4_(wg[q][1]);
                f32x4 sg; sg.x = siluf(gt.x); sg.y = siluf(gt.y); sg.z = siluf(gt.z); sg.w = siluf(gt.w);
                st_bf4(F.Y + (size_t)row * D + 512 + c, o * rsqrtf(ms + 1e-6f) * dng * sg);
            }
        }
    }
}

#define GRID_BARRIER() do { unsigned char* ws_; { kptr_t kp = (kptr_t)__builtin_amdgcn_kernarg_segment_ptr(); asm volatile("" : "+s"(kp)); ws_ = *(unsigned char* const __attribute__((address_space(4)))*)(kp + 8 * N_INPUTS + 8); } \
    int l_; asm volatile("v_mbcnt_lo_u32_b32 %0, -1, 0\n\tv_mbcnt_hi_u32_b32 %0, -1, %0" : "=v"(l_)); \
    xcd_barrier((unsigned*)(ws_ + WS_CTL) + CW_BAR, (volatile LAS unsigned*)(lds_raw + MISC_OFF + 32), (wave0 == 0) && (l_ == 0)); } while (0)
#define PHASE(idx, ...) do { if (ph_lo <= (idx) && (idx) < ph_hi) { { const int probe_rep = 0; (void)probe_rep; __VA_ARGS__ } if ((idx) + 1 < ph_hi) GRID_BARRIER(); } } while (0)

__device__ __forceinline__ void ph_swiglu(Frame& F, int l, int sub) {
    pg8::Gemm g{F.XN, sub == 0 ? (bf16*)(F.ws + WS_P) : F.W1, M, 5632, 1024, 1024, 1024}; pg8::StaticOrder S; S.init(M, 5632, F.G, F.bid); pg8::EpiSwiglu E{F.H, F.ctl + CW_HDONE + (l * 2 + sub) * 48 * 64, F.ctl + (F.G == 256 ? CW_HLATE : CW_HDONE) + (l * 2 + sub) * 48 * 64};
    pg8::gemm_phase<pg8::EpiSwiglu>(F.lds, F.tid, g, S, E);
}
__device__ __forceinline__ void ph_res(Frame& F, int l, int res_kind, bool from_inputs) {
    pg8::Gemm g; pg8::EpiResNorm E; E.out = F.X; E.modl = F.MOD + (size_t)l * 9 * 9216;
    if (res_kind == 1) { g = pg8::Gemm{F.XN, F.WO, M, 1024, 1024, 1024, 1024}; E.gi = 5; E.coef = 1.f; }
    else { g = pg8::Gemm{F.H, res_kind == 0 ? (bf16*)(F.ws + WS_P + 11 * MiB) : F.W2, M, 1024, FF, FF, FF}; E.gi = (res_kind == 0) ? 2 : 8; E.coef = 0.5f; }
    if (from_inputs) { E.base0 = F.in[I_XP]; E.base1 = F.in[I_XS]; } else { E.base0 = F.X; E.base1 = F.X + (size_t)MC * D; }
    E.final_ = (res_kind == 2 && l == 1);
    const int nl = (res_kind == 2) ? l + 1 : l; E.ni = (res_kind == 2) ? 0 : res_kind + 1;
    E.ng = E.final_ ? F.in[I_FNG] : F.in[I_NG] + (nl * 3 + E.ni) * 1024;
    E.nmod = F.MOD + (size_t)(E.final_ ? 0 : nl) * 9 * 9216;
    E.xn = F.XN; E.xbuf = (float*)(F.ws + WS_XB); E.cnt = F.ctl + CW_SEAM + (l * 3 + res_kind) * 48 * 64; E.xnd = nullptr;
    if (res_kind == 1) { E.ready = nullptr; E.need = 0u; E.lready = nullptr; } else { E.ready = F.ctl + CW_HDONE + (l * 2 + (res_kind >> 1)) * 48 * 64; E.need = 22u * 8u;
        E.lready = (F.G == 256) ? F.ctl + CW_HLATE + (l * 2 + (res_kind >> 1)) * 48 * 64 : nullptr; }
    E.gridG = F.G;
    pg8::StaticOrder S; S.init(M, 1024, F.G, (res_kind != 1 && F.G == 256) ? ((F.bid + 192) & 255) : F.bid);
    pg8::gemm_phase<pg8::EpiResNorm>(F.lds, F.tid, g, S, E);
}
__device__ __forceinline__ void ph_p(Frame& F) {
    pg8::Gemm g{F.XN, F.WIN, M, NP, 1024, 1024, 1024}; pg8::StaticOrder S; S.init(M, NP, F.G, F.bid); pg8::EpiP E{F.P, NP};
    pg8::gemm_phase<pg8::EpiP>(F.lds, F.tid, g, S, E);
}
__device__ __forceinline__ void ph_p_conv(Frame& F, int l) {
    if (F.G == 256) {
        if (l == 0) { mod_layer(F, 1, 160); if (F.bid >= 196) conv_stride(F, l, 0, (F.bid - 196) * 8 + F.wave, 480); }
        else if (F.bid >= 160) conv_stride(F, l, 0, (F.bid - 160) * 8 + F.wave, 768);
    } else { if (l == 0) mod_layer(F, 1, 0); conv_stride(F, l, 0, F.bid * 8 + F.wave, F.G * 8); }
}
__device__ __forceinline__ void ph_branch(Frame& F) {
    const int tid = F.tid, wid = F.wave, lane = F.lane, wr = wid >> 2, wc = wid & 3, fr = lane & 15, fq = lane >> 4;
    unsigned voffA[2], voffB[2];
#pragma unroll
    for (int i = 0; i < 2; ++i) { int R, C; pg8::stage_rc(tid * 16 + i * 8192, R, C); voffA[i] = (unsigned)(R * 1024 + C) * 2u; voffB[i] = (unsigned)(R * 256 + C) * 2u; }
    const unsigned ldsw = (unsigned)wid * 1024u;
    const int aoff = pg8::lds_byte(wr * 64 + fr, fq * 8), boff = pg8::lds_byte(wc * 32 + fr, fq * 8);
    LAS unsigned char* lds = F.lds;
    constexpr int GOFF = 3 * 32768;
    const bool xo = (F.G == 256);
    const int k0 = xo ? (F.bid >> 3) : F.bid, kstep = xo ? 32 : F.G, kend = xo ? 96 : 768;
    const int nunits = (k0 < kend) ? (kend - k0 + kstep - 1) / kstep : 0, ntiles = nunits * 16;
    if (ntiles == 0) return;
#define BR_UNIT(ui_, pm_, pn_) const int kq_ = k0 + (ui_) * kstep; const int pm_ = xo ? 8 * (kq_ >> 3) + (F.bid & 7) : (kq_ >> 3), pn_ = kq_ & 7;
#define BR_STAGE(g_) do { BR_UNIT((g_) >> 4, spm_, spn_) const int kt_ = (g_) & 15, m_ = kt_ >> 2, kk_ = kt_ & 3; \
        const char* sa_ = (const char*)(F.Y + (size_t)spm_ * 128 * 1024) + (size_t)(256 * m_ + 64 * kk_) * 2; \
        const char* sb_ = (const char*)(F.WB + (size_t)spn_ * 128 * 256) + ((size_t)m_ * 1024 * 256 + 64 * kk_) * 2; \
        const int bo_ = ((g_) % 3) * 32768; \
        _Pragma("unroll") for (int i_ = 0; i_ < 2; ++i_) { \
            __builtin_amdgcn_global_load_lds((const unsigned*)(sa_ + voffA[i_]), (LAS unsigned*)(lds + bo_ + ldsw + i_ * 8192), 16, 0, 0); \
            __builtin_amdgcn_global_load_lds((const unsigned*)(sb_ + voffB[i_]), (LAS unsigned*)(lds + bo_ + 16384 + ldsw + i_ * 8192), 16, 0, 0); } } while (0)
    BR_STAGE(0); BR_STAGE(1);
    f32x4 mg[4][2], U[4][2];
#pragma unroll
    for (int mm = 0; mm < 4; ++mm)
#pragma unroll
        for (int n = 0; n < 2; ++n) { mg[mm][n] = (f32x4){0.f, 0.f, 0.f, 0.f}; U[mm][n] = (f32x4){0.f, 0.f, 0.f, 0.f}; }
#pragma unroll 1
    for (int g = 0; g < ntiles; ++g) {
        BR_UNIT(g >> 4, pm, pn)
        const int kt = g & 15, row0 = pm * 128, n0 = pn * 128, cb = g % 3;
        if (g + 1 >= ntiles) asm volatile("s_waitcnt vmcnt(0)" ::: "memory");
        else if (((g - 1) & 3) == 0) asm volatile("s_waitcnt vmcnt(8)" ::: "memory");
        else asm volatile("s_waitcnt vmcnt(4)" ::: "memory");
        __builtin_amdgcn_s_barrier(); asm volatile("" ::: "memory");
        if ((kt & 3) == 0) {
            const bf16* gsrc = F.P + (size_t)row0 * NP + PG + 1024 * (kt >> 2) + n0;
#pragma unroll
            for (int p = 0; p < 4; ++p) { const int q = p * 512 + tid, grow = q >> 4, gch = q & 15;
                __builtin_amdgcn_global_load_lds((const unsigned*)(gsrc + (size_t)grow * NP + gch * 8), (LAS unsigned*)(lds + GOFF + (p * 8 + wid) * 1040), 16, 0, 0); }
        }
        if (g + 2 < ntiles) BR_STAGE(g + 2);
        bf16x8 At[4][2], Bt[2][2];
#pragma unroll
        for (int mm = 0; mm < 4; ++mm)
#pragma unroll
            for (int k = 0; k < 2; ++k) At[mm][k] = *(const LAS bf16x8*)(lds + cb * 32768 + aoff + mm * 2048 + k * 1024);
#pragma unroll
        for (int n = 0; n < 2; ++n)
#pragma unroll
            for (int k = 0; k < 2; ++k) Bt[n][k] = *(const LAS bf16x8*)(lds + cb * 32768 + 16384 + boff + n * 2048 + k * 1024);
#pragma unroll
        for (int mm = 0; mm < 4; ++mm)
#pragma unroll
            for (int n = 0; n < 2; ++n)
#pragma unroll
                for (int k = 0; k < 2; ++k) U[mm][n] = __builtin_amdgcn_mfma_f32_16x16x32_bf16(Bt[n][k], At[mm][k], U[mm][n], 0, 0, 0);
        if ((kt & 3) == 3) {
#pragma unroll
            for (int mm = 0; mm < 4; ++mm)
#pragma unroll
                for (int n = 0; n < 2; ++n) {
                    const int rl = wr * 64 + mm * 16 + fr, cl = wc * 32 + n * 16 + 4 * fq;
                    const u32x2 gw = *(const LAS u32x2*)(lds + GOFF + (rl >> 2) * 1040 + (rl & 3) * 256 + cl * 2);
                    f32x4 gv; gv.x = __uint_as_float(gw.x << 16); gv.y = __uint_as_float(gw.x & 0xffff0000u); gv.z = __uint_as_float(gw.y << 16); gv.w = __uint_as_float(gw.y & 0xffff0000u);
                    const f32x4 sg = (f32x4){sigm(gv.x), sigm(gv.y), sigm(gv.z), sigm(gv.w)};
                    mg[mm][n] += sg * U[mm][n]; U[mm][n] = (f32x4){0.f, 0.f, 0.f, 0.f};
                }
        }
        if (kt == 15) {
#pragma unroll
            for (int mm = 0; mm < 4; ++mm)
#pragma unroll
                for (int n = 0; n < 2; ++n) {
                    const int row = row0 + wr * 64 + mm * 16 + fr, col = n0 + wc * 32 + n * 16 + 4 * fq;
                    u32x2 w; w.x = cvtpk(mg[mm][n].x, mg[mm][n].y); w.y = cvtpk(mg[mm][n].z, mg[mm][n].w);
                    *(u32x2*)(F.XN + (size_t)row * D + col) = w; mg[mm][n] = (f32x4){0.f, 0.f, 0.f, 0.f};
                }
        }
        asm volatile("s_waitcnt lgkmcnt(0)" ::: "memory");
    }
    asm volatile("s_waitcnt vmcnt(0)" ::: "memory"); __syncthreads();
#undef BR_STAGE
#undef BR_UNIT
}
#ifndef PROBE_ST
#define PROBE_ST -1
#endif
#define LPHASE(st, ...) do { if (PROBE_ST == (st)) { { const int probe_rep = 1; (void)probe_rep; __VA_ARGS__ } GRID_BARRIER(); } PHASE(B0 + (st), __VA_ARGS__); } while (0)
__device__ __forceinline__ void ph_lora(Frame& F, int l) {
    pg8::Gemm g{F.XN, (const bf16*)(F.ws + WS_WL), M, 1280, 512, 512, 512}; pg8::StaticOrder S; S.init(M, 1280, F.G, F.bid);
    pg8::EpiFeat E{F.FEAT, F.in[I_W0] + l * 512, F.in[I_A0] + l * 512};
    pg8::gemm_phase<pg8::EpiFeat>(F.lds, F.tid, g, S, E);
}
template <int L>
__device__ __forceinline__ void run_layer(LAS unsigned char* lds_raw, const int wave0, const int ph_lo, const int ph_hi) {
    constexpr int B0 = 2 + 10 * L;
    LPHASE(0, MKFRAME(); ph_swiglu(F, L, 0); ph_res(F, L, 0, L == 0); if (L == 0) conv_idle(F, 0, 5, 1););
    LPHASE(1, MKFRAME(); ph_p(F); ph_p_conv(F, L););
    LPHASE(2, MKFRAME(); pre_phase(F, L););
    LPHASE(3, MKFRAME(); ph_lora(F, L););
    LPHASE(4, MKFRAME(); scan_phase(F, L, L + 2 * probe_rep););
    LPHASE(5, MKFRAME(); post_phase(F, L););
    LPHASE(6, MKFRAME(); ph_branch(F););
    LPHASE(7, MKFRAME(); ph_res(F, L, 1, false); if (L == 0) conv_idle(F, 1, 2, 0););
    LPHASE(8, MKFRAME(); ph_swiglu(F, L, 1); ph_res(F, L, 2, false); if (L == 0) conv_idle(F, 1, 3, 1););
}

__global__ void __launch_bounds__(512, 2) mega_fwd(Args a) {
    extern __shared__ __attribute__((aligned(16))) unsigned char lds_raw_[];
    LAS unsigned char* lds_raw = (LAS unsigned char*)lds_raw_;
    cg::grid_group grid = cg::this_grid();
    const int ph_lo = a.ph_lo, ph_hi = a.ph_hi;
    const int wave0 = __builtin_amdgcn_readfirstlane((int)(threadIdx.x >> 6));
    {
        volatile LAS unsigned* st0 = (volatile LAS unsigned*)(lds_raw + MISC_OFF + 32);
        if (threadIdx.x < 2) st0[threadIdx.x] = 0u;
        __syncthreads();
        if (threadIdx.x == 0) (void)xb_add((unsigned*)(a.ws + WS_CTL) + CW_BAR + XB_XCNT(xb_xcc_id()), 1u);
    }
    if (ph_hi > 100000) grid.sync();
    PHASE(0, MKFRAME(); phase0(F););
    PHASE(1, MKFRAME(); norm_phase(F, 0, 0, false, false););
    run_layer<0>(lds_raw, wave0, ph_lo, ph_hi);
    run_layer<1>(lds_raw, wave0, ph_lo, ph_hi);
}

extern "C" void kernel_launch(void* const* d_in, const int* in_sizes, int n_in, void* d_out, int out_size, void* d_ws, size_t ws_size, hipStream_t stream) {
    static int grid = 0;
    if (grid == 0) {
        if (n_in != N_INPUTS || (size_t)out_size != O_END || ws_size < WS_END) { fprintf(stderr, "kernel_launch: unexpected shapes: n_in %d out %d ws %zu (need %zu)\n", n_in, out_size, ws_size, (size_t)WS_END); grid = -1; return; }
        int dev = 0, cus = 0, per_cu = 0;
        hipGetDevice(&dev); hipDeviceGetAttribute(&cus, hipDeviceAttributeMultiprocessorCount, dev);
        if (hipFuncSetAttribute((const void*)mega_fwd, hipFuncAttributeMaxDynamicSharedMemorySize, LDS_BYTES) != hipSuccess) { fprintf(stderr, "kernel_launch: hipFuncSetAttribute failed\n"); grid = -1; return; }
        if (hipOccupancyMaxActiveBlocksPerMultiprocessor(&per_cu, (const void*)mega_fwd, 512, LDS_BYTES) != hipSuccess || per_cu < 1) { fprintf(stderr, "kernel_launch: occupancy query says %d\n", per_cu); per_cu = 1; }
        (void)hipGetLastError();
        grid = cus * 1;
        fprintf(stderr, "kernel_launch: cus %d per_cu %d grid %d ws %zu\n", cus, per_cu, grid, ws_size);
    }
    if (grid < 0) return;
    hipMemsetAsync((char*)d_ws + WS_CTL, 0, CTL_BYTES, stream);
    Args a{};
    for (int i = 0; i < N_INPUTS; ++i) a.in[i] = (const float*)d_in[i];
    a.out = (float*)d_out; a.ws = (unsigned char*)d_ws;
#ifndef MK_SPLIT
    a.ph_lo = 0; a.ph_hi = NPH;
    void* args[] = {&a};
    hipError_t e = hipLaunchCooperativeKernel((const void*)mega_fwd, dim3(grid), dim3(512), args, LDS_BYTES, stream);
    if (e != hipSuccess) fprintf(stderr, "kernel_launch: cooperative launch failed: %s\n", hipGetErrorString(e));
#else
    for (int ph = 0; ph < NPH; ++ph) {
        a.ph_lo = ph; a.ph_hi = ph + 1;
        void* args[] = {&a};
        hipError_t e = hipLaunchCooperativeKernel((const void*)mega_fwd, dim3(grid), dim3(512), args, LDS_BYTES, stream);
        if (e != hipSuccess) { fprintf(stderr, "kernel_launch: launch %d failed: %s\n", ph, hipGetErrorString(e)); break; }
    }
#endif
}
```

```cpp
#include <hip/hip_runtime.h>
#include <hip/hip_cooperative_groups.h>
#include <cstdio>
#include <cstdint>
namespace cg = cooperative_groups;

#define LAS __attribute__((address_space(3)))
typedef unsigned short bf16;
typedef short bf16x8 __attribute__((ext_vector_type(8)));
typedef short s16x4 __attribute__((ext_vector_type(4)));
typedef float f32x4 __attribute__((ext_vector_type(4)));
typedef float f32x2 __attribute__((ext_vector_type(2)));
typedef float f32x16 __attribute__((ext_vector_type(16)));
typedef unsigned u32x4 __attribute__((ext_vector_type(4)));
typedef unsigned u32x2 __attribute__((ext_vector_type(2)));

constexpr int M = 12288, MC = 4096, D = 1024, FF = 2816, NP = 7680, NIN = 7632;
constexpr int PA = 0, PB = 1184, PC = 1984, PD = 3024, PG = 3536;
constexpr int NFEAT = 1280;
enum { I_XP = 0, I_XS, I_C, I_CK, I_CV, I_SR, I_SG, I_SD, I_CCTX, I_NG, I_WMOD, I_BMOD, I_FW1, I_FW2, I_WIN, I_MU, I_W0, I_WUP, I_A0, I_AUP, I_GUP,
       I_KK, I_KA, I_RK, I_LNG, I_LNB, I_GAU, I_GAB, I_GNG, I_DCV, I_DAL, I_DDT, I_DNG, I_QN, I_KN, I_WBR, I_WOUT, I_FNG, N_INPUTS };
constexpr size_t O_Y = 0, O_CK = 12582912, O_CV = 13631488, O_SR = 14680064, O_SG = 15728640, O_SD = 16252928, O_END = 17301504;
constexpr size_t MiB = 1u << 20;
constexpr size_t WS_CTL = 0, CTL_BYTES = 1 * MiB;
constexpr size_t WS_MOD = 1 * MiB;
constexpr size_t WS_W1 = 2 * MiB;
constexpr size_t WS_W2 = 13 * MiB;
constexpr size_t WS_WIN = 19 * MiB;
constexpr size_t WS_WB = 34 * MiB;
constexpr size_t WS_WO = 36 * MiB;
constexpr size_t WS_WL = 38 * MiB;
constexpr size_t WS_XN = 40 * MiB;
constexpr size_t WS_Y = 64 * MiB;
constexpr size_t WS_P = 88 * MiB;
constexpr size_t WS_FEAT = 268 * MiB;
constexpr size_t WS_YP = 298 * MiB;
constexpr size_t WS_QN = 334 * MiB;
constexpr size_t WS_KN = 340 * MiB;
constexpr size_t WS_VT = 344 * MiB;
constexpr size_t WS_MG = 268 * MiB;
constexpr size_t WS_XB = 348 * MiB;
constexpr size_t WS_END = 349 * MiB;
constexpr int CW_Q = 1024;
constexpr int LDS_BYTES = 147456, MISC_OFF = 143360;
constexpr int NPH = 21;
constexpr int CW_HDONE = 65536;
constexpr int CW_HLATE = 131072;
constexpr int CW_SEAM = 16384;

__device__ __forceinline__ float bf2f(bf16 v) { return __uint_as_float(((unsigned)v) << 16); }
__device__ __forceinline__ unsigned f2bf(float f) { unsigned u = __float_as_uint(f); return (u + 0x7fffu + ((u >> 16) & 1u)) >> 16; }
typedef __bf16 bf16x2_t __attribute__((ext_vector_type(2)));
__device__ __forceinline__ unsigned pk2(float lo, float hi) { f32x2 v = {lo, hi}; bf16x2_t b = __builtin_convertvector(v, bf16x2_t); return __builtin_bit_cast(unsigned, b); }
__device__ __forceinline__ unsigned cvtpk(float lo, float hi) { f32x2 v = {lo, hi}; bf16x2_t b = __builtin_convertvector(v, bf16x2_t); return __builtin_bit_cast(unsigned, b); }
#define DPPF(v, ctrl) __int_as_float(__builtin_amdgcn_update_dpp(0, __float_as_int(v), (ctrl), 0xF, 0xF, true))
__device__ __forceinline__ float row16_sum(float v) { v += DPPF(v, 0xB1); v += DPPF(v, 0x4E); v += DPPF(v, 0x141); v += DPPF(v, 0x140); return v; }
__device__ __forceinline__ float swz_xor16(float v) { return __int_as_float(__builtin_amdgcn_ds_swizzle(__float_as_int(v), 0x401F)); }
__device__ __forceinline__ float wave_sum(float v) {
    v = row16_sum(v); v += swz_xor16(v);
    return __int_as_float(__builtin_amdgcn_readlane(__float_as_int(v), 0)) + __int_as_float(__builtin_amdgcn_readlane(__float_as_int(v), 32));
}
__device__ __forceinline__ float xor32(float v, int lane) { return __int_as_float(__builtin_amdgcn_ds_bpermute((lane ^ 32) << 2, __float_as_int(v))); }
__device__ __forceinline__ float sigm(float x) { return __builtin_amdgcn_rcpf(1.f + __expf(-x)); }
__device__ __forceinline__ float siluf(float x) { return x * __builtin_amdgcn_rcpf(1.f + __expf(-x)); }
__device__ __forceinline__ float softplusf(float x) { return fmaxf(x, 0.f) + __logf(1.f + __expf(-fabsf(x))); }
__device__ __forceinline__ float tanhf_(float x) { return 1.f - 2.f * __builtin_amdgcn_rcpf(1.f + __expf(2.f * x)); }
__device__ __forceinline__ float dpp_x1(float v) { return __int_as_float(__builtin_amdgcn_update_dpp(0, __float_as_int(v), 0xB1, 0xF, 0xF, true)); }
__device__ __forceinline__ float dpp_x2(float v) { return __int_as_float(__builtin_amdgcn_update_dpp(0, __float_as_int(v), 0x4E, 0xF, 0xF, true)); }
__device__ __forceinline__ float quad_sum(float v) { v += dpp_x1(v); v += dpp_x2(v); return v; }
__device__ __forceinline__ f32x4 ld_bf4(const bf16* p) { const u32x2 w = *(const u32x2*)p; f32x4 r; r.x = __uint_as_float(w.x << 16); r.y = __uint_as_float(w.x & 0xffff0000u); r.z = __uint_as_float(w.y << 16); r.w = __uint_as_float(w.y & 0xffff0000u); return r; }
__device__ __forceinline__ void st_bf4(bf16* p, f32x4 v) { u32x2 w; w.x = pk2(v.x, v.y); w.y = pk2(v.z, v.w); *(u32x2*)p = w; }
__device__ __forceinline__ f32x4 unbf4_(u32x2 w) { f32x4 r; r.x = __uint_as_float(w.x << 16); r.y = __uint_as_float(w.x & 0xffff0000u); r.z = __uint_as_float(w.y << 16); r.w = __uint_as_float(w.y & 0xffff0000u); return r; }
#define LDS_WAIT() asm volatile("s_waitcnt lgkmcnt(0)" ::: "memory")

namespace pg8 {
#define PG8_LAS __attribute__((address_space(3)))
constexpr int BM = 256, BK = 64, HALF = 128, HTB = HALF * BK * 2, STAGE_BYTES = 8 * HTB, NXCD = 8, WGM = 8;
__host__ __device__ __forceinline__ int lds_byte(int r, int c) { const int st = (r >> 4) * 2 + (c >> 5), rr = r & 15, cc = c & 31, ob = rr * 64 + cc * 2; return st * 1024 + (ob ^ (((ob >> 9) & 1) << 5)); }
__host__ __device__ __forceinline__ void stage_rc(int b, int& R, int& C) { const int st = b / 1024, sb = b % 1024, swz = sb ^ (((sb >> 9) & 1) << 5); R = (st >> 1) * 16 + swz / 64; C = (st & 1) * 32 + (swz % 64) / 2; }
__host__ __device__ __forceinline__ int perm32(int rho) { const int n = rho >> 4, i = rho & 15; return 8 * (i >> 2) + 4 * n + (i & 3); }
struct Unit { int pm, pn, late; };
struct Gemm { const bf16* A; const bf16* Bt; int M, N, K, lda, ldb; };
struct StaticOrder {
    int nM, nN, nwg, G, c;
    __device__ void init(int M_, int N_, int G_, int c_) { nM = M_ / BM; nN = N_ / BM; nwg = nM * nN; G = G_; c = c_; }
    __device__ bool next(int i, Unit& u) const {
        const long L = (long)i * G + c; if (L >= nwg) return false;
        int wgid = (int)L; { const int q = nwg / NXCD, r = nwg % NXCD, xcd = wgid % NXCD, off = wgid / NXCD; wgid = (xcd < r ? xcd * (q + 1) : r * (q + 1) + (xcd - r) * q) + off; }
        const int nig = WGM * nN, gid = wgid / nig, fm = gid * WGM, gsz = (nM - fm) < WGM ? (nM - fm) : WGM;
        u.pm = fm + ((wgid % nig) % gsz); u.pn = (wgid % nig) / gsz; u.late = (L >= (long)(nwg / G) * G) ? 1 : 0; return true;
    }
};
__device__ __forceinline__ unsigned cvt_pk_bf16(float lo, float hi) { unsigned r; asm volatile("v_cvt_pk_bf16_f32 %0, %1, %2" : "=v"(r) : "v"(lo), "v"(hi)); return r; }

struct EpiSwiglu {
    static constexpr bool PERM = true, AFTER_DRAIN = false, KPERM = false, ALIGN_EPI = false;
    bf16* H; unsigned* done_cnt; unsigned* late_cnt;
    __device__ __forceinline__ void operator()(const f32x4 (&acc)[2][2][4][2], const Unit& u, int wr, int wc, int fr, int fq) const {
        const int row0 = u.pm * BM + wr * 64 + fr, col0 = u.pn * 128 + wc * 32 + 8 * fq;
        const __amdgpu_buffer_rsrc_t rsrc = __builtin_amdgcn_make_buffer_rsrc((void*)H, 0, M * FF * 2, 0x00020000);
#pragma unroll
        for (int ai = 0; ai < 2; ++ai)
#pragma unroll
            for (int m = 0; m < 4; ++m) {
                const unsigned off = (unsigned)((row0 + ai * HALF + m * 16) * FF + col0) * 2u;
                const f32x4 g0 = acc[ai][0][m][0], g1 = acc[ai][0][m][1], u0 = acc[ai][1][m][0], u1 = acc[ai][1][m][1];
                u32x4 w;
                w.x = cvt_pk_bf16(siluf(g0[0]) * u0[0], siluf(g0[1]) * u0[1]); w.y = cvt_pk_bf16(siluf(g0[2]) * u0[2], siluf(g0[3]) * u0[3]);
                w.z = cvt_pk_bf16(siluf(g1[0]) * u1[0], siluf(g1[1]) * u1[1]); w.w = cvt_pk_bf16(siluf(g1[2]) * u1[2], siluf(g1[3]) * u1[3]);
                __builtin_amdgcn_raw_buffer_store_b128(w, rsrc, off, 0,   16);
            }
    }
    __device__ __forceinline__ void publish(const Unit& u, int lane) const { if (lane == 0) __hip_atomic_fetch_add((u.late ? late_cnt : done_cnt) + 64 * u.pm, 1u, __ATOMIC_RELAXED, __HIP_MEMORY_SCOPE_AGENT); }
    __device__ __forceinline__ void a_ready(const Unit&, int, int) const {}
};
struct EpiRes {
    static constexpr bool PERM = false, AFTER_DRAIN = false, KPERM = false, ALIGN_EPI = true;
    const float* base0; const float* base1; float* out; const float* modl; int gi; float coef;
    __device__ __forceinline__ void publish(const Unit&, int) const {}
    __device__ __forceinline__ void a_ready(const Unit&, int, int) const {}
    __device__ __forceinline__ void operator()(const f32x4 (&acc)[2][2][4][2], const Unit& u, int wr, int wc, int fr, int fq) const {
        const int cond = u.pm < 16 ? 0 : 1 + ((u.pm - 16) >> 2);
        const int row0 = u.pm * BM + wr * 64 + fr, col0 = u.pn * BM + wc * 32 + 4 * fq;
        const float* gv = modl + cond * 9216 + gi * 1024 + col0;
        f32x4 gvv[2][2];
#pragma unroll
        for (int bj = 0; bj < 2; ++bj)
#pragma unroll
            for (int n = 0; n < 2; ++n) gvv[bj][n] = *(const f32x4*)(gv + bj * HALF + n * 16) * coef;
#pragma unroll
        for (int ai = 0; ai < 2; ++ai)
#pragma unroll
            for (int m = 0; m < 4; ++m) {
                const int row = row0 + ai * HALF + m * 16;
                const float* bp = (row < MC ? base0 + (size_t)row * D : base1 + (size_t)(row - MC) * D) + col0;
                float* op = out + (size_t)row * D + col0;
#pragma unroll
                for (int bj = 0; bj < 2; ++bj)
#pragma unroll
                    for (int n = 0; n < 2; ++n) *(f32x4*)(op + bj * HALF + n * 16) = *(const f32x4*)(bp + bj * HALF + n * 16) + gvv[bj][n] * acc[ai][bj][m][n];
            }
    }
};
struct EpiResNorm {
    static constexpr bool PERM = true, AFTER_DRAIN = true, KPERM = true, ALIGN_EPI = true;
    const float* base0; const float* base1; float* out; const float* modl; int gi; float coef;
    const float* ng; const float* nmod; int ni; bf16* xn; float* xbuf; unsigned* cnt; bool final_;
    unsigned* xnd;
    const unsigned* ready; unsigned need;
    const unsigned* lready; int gridG;
    __device__ __forceinline__ int late_pn(const Unit& u) const {
        if (lready == nullptr) return -1;
        StaticOrder S; S.init(M, 2 * FF, gridG, 0); int r = -1;
        for (int L = (S.nwg / gridG) * gridG; L < S.nwg; ++L) { Unit v; S.c = L % gridG; S.next(L / gridG, v); if (v.pm == u.pm) r = v.pn; }
        return r;
    }
    __device__ __forceinline__ void late_wait(const Unit& u, int wid) const {
        int w_ = wid; asm volatile("" : "+s"(w_));
        if (w_ == 0) {
            unsigned spins = 0;
            while ((unsigned)__builtin_amdgcn_readfirstlane(__hip_atomic_load(lready + 64 * u.pm, __ATOMIC_RELAXED, __HIP_MEMORY_SCOPE_AGENT)) < 8u) { __builtin_amdgcn_s_sleep(2); if (++spins > (1u << 22)) break; }
            __builtin_amdgcn_fence(__ATOMIC_ACQUIRE, "agent");
            asm volatile("s_waitcnt vmcnt(0)" ::: "memory");
        }
        asm volatile("" ::: "memory"); __builtin_amdgcn_s_barrier(); asm volatile("" ::: "memory");
    }
    __device__ __forceinline__ void publish(const Unit&, int) const {}
    __device__ __forceinline__ void a_ready(const Unit& u, int wid, int lane) const {
        if (ready == nullptr) return;
        if (wid == 0) {
            unsigned spins = 0;
            const unsigned need_ = (late_pn(u) >= 0) ? need - 8u : need;
            while ((unsigned)__builtin_amdgcn_readfirstlane(__hip_atomic_load(ready + 64 * u.pm, __ATOMIC_RELAXED, __HIP_MEMORY_SCOPE_AGENT)) < need_) { __builtin_amdgcn_s_sleep(2); if (++spins > (1u << 22)) break; }
            __builtin_amdgcn_fence(__ATOMIC_ACQUIRE, "agent");
            asm volatile("s_waitcnt vmcnt(0)" ::: "memory");
        }
        asm volatile("" ::: "memory"); __builtin_amdgcn_s_barrier(); asm volatile("" ::: "memory");
    }
    __device__ __forceinline__ void fused(f32x4 (&acc)[2][2][4][2], const Unit& u, int wr, int wc, int fr, int fq, PG8_LAS unsigned char* lds, int wid, int lane) const {
        PG8_LAS float* P = (PG8_LAS float*)lds;
        PG8_LAS float* S = (PG8_LAS float*)(lds + 4096);
        const int cond = u.pm < 16 ? 0 : 1 + ((u.pm - 16) >> 2);
        const int row0 = u.pm * BM + wr * 64 + fr, col0 = u.pn * BM + wc * 32 + 8 * fq;
        {
            const float* gv = modl + cond * 9216 + gi * 1024 + col0;
            f32x4 gvv[2][2];
#pragma unroll
            for (int bj = 0; bj < 2; ++bj)
#pragma unroll
                for (int n = 0; n < 2; ++n) gvv[bj][n] = *(const f32x4*)(gv + bj * HALF + n * 4) * coef;
#pragma unroll
            for (int ai = 0; ai < 2; ++ai)
#pragma unroll
                for (int m = 0; m < 4; ++m) {
                    const int row = row0 + ai * HALF + m * 16;
                    const float* bp = (row < MC ? base0 + (size_t)row * D : base1 + (size_t)(row - MC) * D) + col0;
                    float* op = out + (size_t)row * D + col0;
                    float s = 0.f;
#pragma unroll
                    for (int bj = 0; bj < 2; ++bj)
#pragma unroll
                        for (int n = 0; n < 2; ++n) { const f32x4 x = *(const f32x4*)(bp + bj * HALF + n * 4) + gvv[bj][n] * acc[ai][bj][m][n]; acc[ai][bj][m][n] = x;
                            if (!final_) *(f32x4*)(op + bj * HALF + n * 4) = x;
                            s += (x[0] * x[0] + x[1] * x[1]) + (x[2] * x[2] + x[3] * x[3]); }
                    s += swz_xor16(s); s += xor32(s, lane);
                    if (fq == 0) P[(ai * HALF + wr * 64 + m * 16 + fr) * 4 + wc] = s;
                    if (m & 1) asm volatile("" ::: "memory");
                }
        }
        asm volatile("s_waitcnt lgkmcnt(0)" ::: "memory"); __builtin_amdgcn_s_barrier(); asm volatile("" ::: "memory");
        const int row = wid * 32 + (lane & 31);
        if (lane < 32) {
            const f32x4 p4 = *(const PG8_LAS f32x4*)(P + row * 4);
            __hip_atomic_store(xbuf + ((size_t)(u.pm * BM + row) * 4 + u.pn), (p4[0] + p4[1]) + (p4[2] + p4[3]), __ATOMIC_RELAXED, __HIP_MEMORY_SCOPE_AGENT);
        }
        asm volatile("s_waitcnt vmcnt(0)" ::: "memory");
        if (lane == 0) __hip_atomic_fetch_add(cnt + 64 * u.pm, 1u, __ATOMIC_RELAXED, __HIP_MEMORY_SCOPE_AGENT);
        if (wid == 0) {
            unsigned spins = 0;
            while ((unsigned)__builtin_amdgcn_readfirstlane(__hip_atomic_load(cnt + 64 * u.pm, __ATOMIC_RELAXED, __HIP_MEMORY_SCOPE_AGENT)) < 32u) { __builtin_amdgcn_s_sleep(2); if (++spins > (1u << 22)) break; }
            __builtin_amdgcn_fence(__ATOMIC_ACQUIRE, "agent");
        }
        asm volatile("s_waitcnt vmcnt(0) lgkmcnt(0)" ::: "memory"); __builtin_amdgcn_s_barrier(); asm volatile("" ::: "memory");
        if (lane < 32) {
            const float* slot = xbuf + (size_t)(u.pm * BM + row) * 4; float t = 0.f;
#pragma unroll
            for (int q = 0; q < 4; ++q) t += __hip_atomic_load(slot + q, __ATOMIC_RELAXED, __HIP_MEMORY_SCOPE_AGENT);
            S[row] = rsqrtf(t * (1.f / 1024.f) + 1e-6f);
        }
        asm volatile("s_waitcnt vmcnt(0) lgkmcnt(0)" ::: "memory"); __builtin_amdgcn_s_barrier(); asm volatile("" ::: "memory");
        f32x4 g4[2][2], sc4[2][2], sh4[2][2];
        const __amdgpu_buffer_rsrc_t xrs = __builtin_amdgcn_make_buffer_rsrc((void*)xn, 0, M * D * 2, 0x00020000);
#pragma unroll
        for (int bj = 0; bj < 2; ++bj)
#pragma unroll
            for (int n = 0; n < 2; ++n) {
                const int c = col0 + bj * HALF + n * 4;
                g4[bj][n] = *(const f32x4*)(ng + c);
                if (!final_) { const float* mp = nmod + (size_t)cond * 9216 + (3 * ni) * 1024 + c; sh4[bj][n] = *(const f32x4*)mp; sc4[bj][n] = *(const f32x4*)(mp + 1024) + 1.f; g4[bj][n] = g4[bj][n] * sc4[bj][n]; }
            }
#pragma unroll
        for (int ai = 0; ai < 2; ++ai)
#pragma unroll
            for (int m = 0; m < 4; ++m) {
                const int r = ai * HALF + wr * 64 + m * 16 + fr; const float rs = S[r]; const size_t off = (size_t)(u.pm * BM + r) * D + col0;
#pragma unroll
                for (int bj = 0; bj < 2; ++bj) {
                    const f32x4 y0 = acc[ai][bj][m][0] * rs * g4[bj][0], y1 = acc[ai][bj][m][1] * rs * g4[bj][1];
                    if (final_) { *(f32x4*)(out + off + bj * HALF) = y0; *(f32x4*)(out + off + bj * HALF + 4) = y1; }
                    else { const f32x4 z0 = y0 + sh4[bj][0], z1 = y1 + sh4[bj][1]; u32x4 w; w.x = cvt_pk_bf16(z0[0], z0[1]); w.y = cvt_pk_bf16(z0[2], z0[3]); w.z = cvt_pk_bf16(z1[0], z1[1]); w.w = cvt_pk_bf16(z1[2], z1[3]);
                        __builtin_amdgcn_raw_buffer_store_b128(w, xrs, (unsigned)(off + bj * HALF) * 2u, 0,   16); }
                }
            }
        if (xnd != nullptr) { asm volatile("s_waitcnt vmcnt(0)" ::: "memory"); if (lane == 0) __hip_atomic_fetch_add(xnd + 64 * u.pm, 1u, __ATOMIC_RELAXED, __HIP_MEMORY_SCOPE_AGENT); }
    }
};
struct EpiP {
    static constexpr bool PERM = true, AFTER_DRAIN = false, KPERM = false, ALIGN_EPI = true;
    bf16* O; int ldc;
    __device__ __forceinline__ void publish(const Unit&, int) const {}
    __device__ __forceinline__ void a_ready(const Unit&, int, int) const {}
    __device__ __forceinline__ void operator()(const f32x4 (&acc)[2][2][4][2], const Unit& u, int wr, int wc, int fr, int fq) const {
        const int row0 = u.pm * BM + wr * 64 + fr, col0 = u.pn * BM + wc * 32 + 8 * fq;
#pragma unroll
        for (int ai = 0; ai < 2; ++ai)
#pragma unroll
            for (int m = 0; m < 4; ++m) {
                bf16* rowp = O + (size_t)(row0 + ai * HALF + m * 16) * ldc + col0;
#pragma unroll
                for (int bj = 0; bj < 2; ++bj) {
                    const f32x4 v0 = acc[ai][bj][m][0], v1 = acc[ai][bj][m][1];
                    u32x4 w; w.x = cvt_pk_bf16(v0[0], v0[1]); w.y = cvt_pk_bf16(v0[2], v0[3]); w.z = cvt_pk_bf16(v1[0], v1[1]); w.w = cvt_pk_bf16(v1[2], v1[3]);
                    *(u32x4*)(rowp + bj * HALF) = w;
                }
            }
    }
};
struct EpiFeat {
    static constexpr bool PERM = true, AFTER_DRAIN = false, KPERM = false, ALIGN_EPI = true;
    bf16* O; const float* w0; const float* a0;
    __device__ __forceinline__ void publish(const Unit&, int) const {}
    __device__ __forceinline__ void a_ready(const Unit&, int, int) const {}
    __device__ __forceinline__ void operator()(const f32x4 (&acc)[2][2][4][2], const Unit& u, int wr, int wc, int fr, int fq) const {
        const int row0 = u.pm * BM + wr * 64 + fr, cl = wc * 32 + 8 * fq, kind = u.pn;
        const float* bsrc = (kind < 2) ? w0 + kind * 256 : a0 + ((kind - 2) & 1) * 256;
        f32x4 bv[2][2];
#pragma unroll
        for (int bj = 0; bj < 2; ++bj)
#pragma unroll
            for (int n = 0; n < 2; ++n) bv[bj][n] = (kind < 4) ? *(const f32x4*)(bsrc + cl + bj * HALF + 4 * n) : (f32x4){0.f, 0.f, 0.f, 0.f};
        const float sc = (kind < 2) ? 0.6065306597f : 1.f;
#pragma unroll
        for (int ai = 0; ai < 2; ++ai)
#pragma unroll
            for (int m = 0; m < 4; ++m) {
                bf16* rowp = O + (size_t)(row0 + ai * HALF + m * 16) * NFEAT + kind * 256 + cl;
#pragma unroll
                for (int bj = 0; bj < 2; ++bj) {
                    f32x4 v0 = acc[ai][bj][m][0] + bv[bj][0], v1 = acc[ai][bj][m][1] + bv[bj][1];
                    if (kind < 4) { v0 = (f32x4){sigm(v0[0]), sigm(v0[1]), sigm(v0[2]), sigm(v0[3])} * sc; v1 = (f32x4){sigm(v1[0]), sigm(v1[1]), sigm(v1[2]), sigm(v1[3])} * sc; }
                    u32x4 w; w.x = cvt_pk_bf16(v0[0], v0[1]); w.y = cvt_pk_bf16(v0[2], v0[3]); w.z = cvt_pk_bf16(v1[0], v1[1]); w.w = cvt_pk_bf16(v1[2], v1[3]);
                    *(u32x4*)(rowp + bj * HALF) = w;
                }
            }
    }
};
struct EpiBranch {
    static constexpr bool PERM = false, AFTER_DRAIN = false, KPERM = false, ALIGN_EPI = true;
    int m; const bf16* G; float* MG; bf16* OUT;
    __device__ __forceinline__ void publish(const Unit&, int) const {}
    __device__ __forceinline__ void a_ready(const Unit&, int, int) const {}
    __device__ __forceinline__ void operator()(const f32x4 (&acc)[2][2][4][2], const Unit& u, int wr, int wc, int fr, int fq) const {
        const int row0 = u.pm * BM + wr * 64 + fr, col0 = u.pn * BM + wc * 32 + 4 * fq;
#pragma unroll
        for (int ai = 0; ai < 2; ++ai)
#pragma unroll
            for (int mm = 0; mm < 4; ++mm) {
                const int row = row0 + ai * HALF + mm * 16;
#pragma unroll
                for (int bj = 0; bj < 2; ++bj)
#pragma unroll
                    for (int n = 0; n < 2; ++n) {
                        const int col = col0 + bj * HALF + n * 16;
                        const f32x4 g = ld_bf4(G + (size_t)row * NP + col);
                        const f32x4 a = acc[ai][bj][mm][n];
                        f32x4 v; v.x = sigm(g.x) * a.x; v.y = sigm(g.y) * a.y; v.z = sigm(g.z) * a.z; v.w = sigm(g.w) * a.w;
                        float* mp = MG + (size_t)row * D + col;
                        if (m > 0) v += *(const f32x4*)mp;
                        if (m < 3) *(f32x4*)mp = v; else st_bf4(OUT + (size_t)row * D + col, v);
                    }
                asm volatile("" ::: "memory");
            }
    }
};

template <class Epi>
__device__ __forceinline__ void gemm_phase(PG8_LAS unsigned char* lds, const int tid, const Gemm g, const StaticOrder& S, const Epi& E) {
    const int wid = __builtin_amdgcn_readfirstlane(tid >> 6), lane = tid & 63, wr = wid >> 2, wc = wid & 3, fr = lane & 15, fq = lane >> 4;
    const int K = g.K, nt = K / BK;
    unsigned voffA[2], voffB[2];
#pragma unroll
    for (int i = 0; i < 2; ++i) { int R, C; stage_rc(tid * 16 + i * 8192, R, C); const int Rb = Epi::PERM ? ((R & ~31) + perm32(R & 31)) : R;
        voffA[i] = (unsigned)(R * g.lda + C) * 2u; voffB[i] = (unsigned)(Rb * g.ldb + C) * 2u; }
    const size_t kstep = (size_t)(BK * 2);
    const size_t hstepA = (size_t)HALF * g.lda * 2, hstepB = (size_t)HALF * g.ldb * 2;
    const size_t tstepA = 2 * hstepA, tstepB = 2 * hstepB;
    const unsigned ldsw = (unsigned)wid * 1024u;
    const int aoff = lds_byte(wr * 64 + fr, fq * 8), boff = lds_byte(wc * 32 + fr, fq * 8);
#define PG8_SA(b, h) (((b) * 2 + (h)) * HTB)
#define PG8_SB(b, h) ((4 + (b) * 2 + (h)) * HTB)
#define PG8_STAGE(bufoff, gbase, voff) do { _Pragma("unroll") for (int _i = 0; _i < 2; ++_i) \
        __builtin_amdgcn_global_load_lds((const unsigned*)((const char*)(gbase) + (voff)[_i]), (PG8_LAS unsigned*)(lds + (bufoff) + ldsw + _i * 8192), 16, 0, 0); } while (0)
#define PG8_LDA(dst, b, h) do { _Pragma("unroll") for (int m = 0; m < 4; ++m) _Pragma("unroll") for (int k = 0; k < 2; ++k) dst[m][k] = *(const PG8_LAS bf16x8*)(lds + PG8_SA(b, h) + aoff + m * 2048 + k * 1024); } while (0)
#define PG8_LDB(dst, b, h) do { _Pragma("unroll") for (int n = 0; n < 2; ++n) _Pragma("unroll") for (int k = 0; k < 2; ++k) dst[n][k] = *(const PG8_LAS bf16x8*)(lds + PG8_SB(b, h) + boff + n * 2048 + k * 1024); } while (0)
#define PG8_MMA(ai, bj, At, Bt) do { __builtin_amdgcn_s_setprio(1); _Pragma("unroll") for (int m = 0; m < 4; ++m) _Pragma("unroll") for (int n = 0; n < 2; ++n) _Pragma("unroll") for (int k = 0; k < 2; ++k) \
        acc[ai][bj][m][n] = __builtin_amdgcn_mfma_f32_16x16x32_bf16(Bt[n][k], At[m][k], acc[ai][bj][m][n], 0, 0, 0); __builtin_amdgcn_s_setprio(0); } while (0)
#define PG8_WAIT_V(n) asm volatile("s_waitcnt vmcnt(" #n ")" ::: "memory")
#define PG8_WAIT_L(n) asm volatile("s_waitcnt lgkmcnt(" #n ")" ::: "memory")
#define PG8_BAR __builtin_amdgcn_s_barrier()
#define PG8_SCHED __builtin_amdgcn_sched_barrier(0)
    Unit cur, nxt; int ui = 0;
    if (!S.next(0, cur)) return;
    int pl2 = nt - 2; bool haslate = false;
    if constexpr (Epi::KPERM) { const int lp = E.late_pn(cur); if (lp >= 0) { pl2 = 2 * lp; haslate = true; } }
    auto koff = [&](int tile) -> size_t { if constexpr (!Epi::KPERM) return (size_t)tile * kstep; else return (size_t)(tile < pl2 ? tile : (tile < nt - 2 ? tile + 2 : tile - (nt - 2) + pl2)) * kstep; };
    f32x4 acc[2][2][4][2];
#pragma unroll
    for (int a = 0; a < 2; ++a)
#pragma unroll
        for (int b = 0; b < 2; ++b)
#pragma unroll
            for (int m = 0; m < 4; ++m)
#pragma unroll
                for (int n = 0; n < 2; ++n) acc[a][b][m][n] = (f32x4){0.f, 0.f, 0.f, 0.f};
    bf16x8 At[4][2], B0[2][2], B1[2][2];
    const char* cA = (const char*)g.A + (size_t)cur.pm * tstepA; const char* cB = (const char*)g.Bt + (size_t)cur.pn * tstepB;
    E.a_ready(cur, wid, lane);
    Unit prev = cur;
    { const size_t k0_ = koff(0);
    PG8_STAGE(PG8_SB(0, 0), cB + k0_, voffB); PG8_STAGE(PG8_SB(0, 1), cB + k0_ + hstepB, voffB); PG8_STAGE(PG8_SA(0, 0), cA + k0_, voffA); PG8_STAGE(PG8_SA(0, 1), cA + k0_ + hstepA, voffA);
    if (wr == 1) PG8_BAR;
    PG8_WAIT_V(2); PG8_BAR;
    PG8_STAGE(PG8_SB(1, 0), cB + k0_ + kstep, voffB); PG8_STAGE(PG8_SA(1, 0), cA + k0_ + kstep, voffA); PG8_STAGE(PG8_SB(1, 1), cB + k0_ + hstepB + kstep, voffB); }
    PG8_WAIT_V(6); PG8_BAR;
    for (;;) {
        const bool has_next = S.next(ui + 1, nxt);
        const char* nA = has_next ? (const char*)g.A + (size_t)nxt.pm * tstepA : cA; const char* nB = has_next ? (const char*)g.Bt + (size_t)nxt.pn * tstepB : cB;
        for (int t = 0; t < nt; t += 2) {
            const bool last = (t == nt - 2);
            if constexpr (Epi::KPERM) { if (haslate && t == nt - 4) E.late_wait(cur, wid); }
            const char* a1 = cA + koff(t) + kstep;
            const char* a2 = last ? nA : cA + koff(t + 2); const char* b2 = last ? nB : cB + koff(t + 2);
            const char* a3 = a2 + kstep; const char* b3 = b2 + kstep;
            PG8_LDB(B0, 0, 0); PG8_LDB(B1, 0, 1); PG8_SCHED; PG8_LDA(At, 0, 0); PG8_STAGE(PG8_SA(1, 1), a1 + hstepA, voffA);
            PG8_WAIT_V(8); PG8_WAIT_L(0); PG8_BAR; PG8_MMA(0, 0, At, B0); PG8_MMA(0, 1, At, B1); PG8_BAR; PG8_SCHED;
            PG8_LDA(At, 0, 1); PG8_STAGE(PG8_SB(0, 0), b2, voffB); PG8_STAGE(PG8_SB(0, 1), b2 + hstepB, voffB); PG8_STAGE(PG8_SA(0, 0), a2, voffA);
            PG8_WAIT_V(8); PG8_WAIT_L(0); PG8_BAR; PG8_MMA(1, 0, At, B0); PG8_MMA(1, 1, At, B1); PG8_BAR; PG8_SCHED;
            PG8_LDB(B0, 1, 0); PG8_LDB(B1, 1, 1); PG8_SCHED; PG8_LDA(At, 1, 0); PG8_STAGE(PG8_SA(0, 1), a2 + hstepA, voffA);
            PG8_WAIT_V(8); PG8_WAIT_L(0); PG8_BAR; PG8_MMA(0, 0, At, B0); PG8_MMA(0, 1, At, B1); PG8_BAR; PG8_SCHED;
            PG8_LDA(At, 1, 1); PG8_STAGE(PG8_SB(1, 0), b3, voffB); PG8_STAGE(PG8_SB(1, 1), b3 + hstepB, voffB); PG8_STAGE(PG8_SA(1, 0), a3, voffA);
            PG8_WAIT_V(8); PG8_WAIT_L(0); PG8_BAR; PG8_MMA(1, 0, At, B0); PG8_MMA(1, 1, At, B1); PG8_BAR; PG8_SCHED;
            if (t == 0 && ui > 0) E.publish(prev, lane);
        }
        if (wr == 0 && (!has_next || Epi::ALIGN_EPI)) PG8_BAR;
        if constexpr (!Epi::AFTER_DRAIN) E(acc, cur, wr, wc, fr, fq);
        if (!has_next) break;
#pragma unroll
        for (int a = 0; a < 2; ++a)
#pragma unroll
            for (int b = 0; b < 2; ++b)
#pragma unroll
                for (int m = 0; m < 4; ++m)
#pragma unroll
                    for (int n = 0; n < 2; ++n) acc[a][b][m][n] = (f32x4){0.f, 0.f, 0.f, 0.f};
        prev = cur; cur = nxt; cA = nA; cB = nB; ++ui;
        if (wr == 1 && Epi::ALIGN_EPI) PG8_BAR;
    }
    PG8_WAIT_V(0);
    E.publish(cur, lane);
    PG8_BAR;
    if constexpr (Epi::AFTER_DRAIN) E.fused(acc, cur, wr, wc, fr, fq, lds, wid, lane);
#undef PG8_SA
#undef PG8_SB
#undef PG8_STAGE
#undef PG8_LDA
#undef PG8_LDB
#undef PG8_MMA
#undef PG8_WAIT_V
#undef PG8_WAIT_L
#undef PG8_BAR
#undef PG8_SCHED
}
}


#define XB_TMO      128
#define XB_XCNT(j)  (256  + 64 * (j))
#define XB_XSUB(j)  (1280 + 64 * (j))
#define XB_XGEN(j)  (2304 + 64 * (j))
#define XB_TOP      3328
#define XB_TOPGEN   3392
#define XCD_BAR_WORDS 3456
#define XB_SPIN_CAP (1u << 18)
constexpr int CW_BAR = 4096;
__device__ __forceinline__ unsigned xb_ld(unsigned* p)              { return __hip_atomic_load(p, __ATOMIC_RELAXED, __HIP_MEMORY_SCOPE_AGENT); }
__device__ __forceinline__ unsigned xb_add(unsigned* p, unsigned v) { return __hip_atomic_fetch_add(p, v, __ATOMIC_RELAXED, __HIP_MEMORY_SCOPE_AGENT); }
__device__ __forceinline__ unsigned xb_xcc_id() { return (unsigned)__builtin_amdgcn_s_getreg((3 << 11) | 20) & 0xFu; }
#define XB_SPIN(cond, bar) do { unsigned _sp = 0; while (cond) { __builtin_amdgcn_s_sleep(1); \
    if ((++_sp & 255u) == 0u) { if (xb_ld(&(bar)[XB_TMO])) break; if (_sp > XB_SPIN_CAP) { atomicAdd(&(bar)[XB_TMO], 1u); break; } } } } while (0)
__device__ __forceinline__ void xcd_barrier_complete(unsigned* bar, unsigned x, unsigned& nloc, unsigned& nx) {
    const unsigned G = gridDim.x * gridDim.y * gridDim.z;
    unsigned sum, cnt, mine, sp = 0u;
    for (;;) {
        sum = 0u; cnt = 0u; mine = 0u;
#pragma unroll
        for (unsigned j = 0; j < 16; ++j) { const unsigned c = xb_ld(&bar[XB_XCNT(j)]); sum += c; cnt += (c > 0u) ? 1u : 0u; mine = (j == x) ? c : mine; }
        if (sum == G) break;
        __builtin_amdgcn_s_sleep(1);
        if ((++sp & 255u) == 0u) { if (xb_ld(&bar[XB_TMO])) break; if (sp > XB_SPIN_CAP) { atomicAdd(&bar[XB_TMO], 1u); break; } }
    }
    nloc = mine > 0u ? mine : 1u; nx = cnt > 0u ? cnt : 1u;
}
__device__ __forceinline__ void xcd_barrier(unsigned* bar, volatile LAS unsigned* st, bool tid0) {
    asm volatile("s_waitcnt vmcnt(0)" ::: "memory");
    __syncthreads();
    if (tid0) {
        const unsigned x = xb_xcc_id();
        __builtin_amdgcn_s_waitcnt(0);
        unsigned nloc = st[0], nx = st[1];
        if (nloc == 0u) { xcd_barrier_complete(bar, x, nloc, nx); st[0] = nloc; st[1] = nx; }
        const unsigned old = xb_add(&bar[XB_XSUB(x)], 1u);
        const unsigned gen = old / nloc;
        if (old + 1u == (gen + 1u) * nloc) {
            __builtin_amdgcn_fence(__ATOMIC_RELEASE, "agent");
            asm volatile("s_waitcnt vmcnt(0)" ::: "memory");
            const unsigned og = xb_add(&bar[XB_TOP], 1u);
            const unsigned tg = og / nx;
            if (og + 1u == (tg + 1u) * nx) xb_add(&bar[XB_TOPGEN], 1u);
            else XB_SPIN(xb_ld(&bar[XB_TOPGEN]) == tg, bar);
            __builtin_amdgcn_fence(__ATOMIC_ACQUIRE, "agent");
            xb_add(&bar[XB_XGEN(x)], 1u);
            asm volatile("s_waitcnt vmcnt(0)" ::: "memory");
        } else {
            XB_SPIN(xb_ld(&bar[XB_XGEN(x)]) == gen, bar);
            __builtin_amdgcn_fence(__ATOMIC_ACQUIRE, "agent");
            asm volatile("s_waitcnt vmcnt(0)" ::: "memory");
        }
    }
    __syncthreads();
}

struct Args { const float* in[N_INPUTS]; float* out; unsigned char* ws; int ph_lo, ph_hi; };
typedef const float* const __attribute__((address_space(4)))* inptr_t;
typedef const __attribute__((address_space(4))) unsigned char* kptr_t;
struct Frame {
    LAS unsigned char* lds; inptr_t in; float* out; unsigned char* ws;
    int tid, lane, wave, G, bid;
    float* X; float* MOD; bf16 *W1, *W2, *WIN, *WB, *WO, *XN, *Y, *P, *H, *FEAT, *YP, *QN, *KN, *VT; float* MG; unsigned* ctl;
};

__device__ __forceinline__ void conv_item(const float* __restrict__ W, int Nsrc, int srccol0, int nvalid, int k0, bf16* WT, int ldd, int n0, LAS float* scr, int lane) {
    const int rr = lane >> 3, ch = lane & 7;
    f32x4 v[8];
    if (nvalid == 32 && ((Nsrc | srccol0) & 3) == 0) {
#pragma unroll
        for (int i = 0; i < 8; ++i) v[i] = *(const f32x4*)(W + (size_t)(k0 + 8 * i + rr) * Nsrc + srccol0 + 4 * ch);
    } else {
#pragma unroll
        for (int i = 0; i < 8; ++i) { const float* p = W + (size_t)(k0 + 8 * i + rr) * Nsrc + srccol0 + 4 * ch;
#pragma unroll
            for (int e = 0; e < 4; ++e) v[i][e] = (4 * ch + e < nvalid) ? p[e] : 0.f; }
    }
#pragma unroll
    for (int i = 0; i < 8; ++i) { LAS float* s = scr + (8 * i + rr) * 33 + 4 * ch; s[0] = v[i].x; s[1] = v[i].y; s[2] = v[i].z; s[3] = v[i].w; }
    LDS_WAIT(); asm volatile("" ::: "memory");
    const int c = lane & 7;
#pragma unroll
    for (int jj = 0; jj < 4; ++jj) { const int n = (lane >> 3) + 8 * jj; const LAS float* s = scr + (8 * c) * 33 + n;
        u32x4 o; o.x = cvtpk(s[0 * 33], s[1 * 33]); o.y = cvtpk(s[2 * 33], s[3 * 33]); o.z = cvtpk(s[4 * 33], s[5 * 33]); o.w = cvtpk(s[6 * 33], s[7 * 33]);
        *(u32x4*)(WT + (size_t)(n0 + n) * ldd + k0 + 8 * c) = o; }
    LDS_WAIT(); asm volatile("" ::: "memory");
}
__device__ __forceinline__ void conv_matrix_item(const float* W, int K, int Nsrc, bf16* WT, int mode, int item, LAS float* scr, int lane) {
    const int nnb = ((Nsrc + 255) >> 8) * 8, nb = item % nnb, kb = item / nnb, n0 = nb * 32;
    int srccol0, nvalid;
    if (mode == 0) { srccol0 = n0; nvalid = Nsrc - n0; nvalid = nvalid < 0 ? 0 : (nvalid > 32 ? 32 : nvalid); }
    else { const int pn = n0 >> 8, rem = n0 & 255, bj = rem >> 7, jj = rem & 127; srccol0 = bj * FF + 128 * pn + jj; nvalid = 32; }
    conv_item(W, Nsrc, srccol0, nvalid, kb * 64, WT, K, n0, scr, lane);
}
__device__ __forceinline__ void conv_set(Frame& F, int l, int set) {
    LAS float* scr = (LAS float*)(F.lds + F.wave * 16384);
    const int gw = F.bid * 8 + F.wave, NGW = F.G * 8;
    constexpr int I_1 = 16 * 176, I_2 = 44 * 32, I_IN = 16 * 240, I_B = 4 * 32, I_O = 16 * 32;
    const int s = set;
    const float* w1 = F.in[I_FW1] + ((size_t)(l * 2 + s)) * 1024 * 5632;
    const float* w2 = F.in[I_FW2] + ((size_t)(l * 2 + s)) * FF * 1024;
    const int total = (set == 0) ? (I_1 + I_2 + I_IN + 4 * I_B + I_O) : (I_1 + I_2);
    for (int it = gw; it < total; it += NGW) {
        int r = it;
        if (r < I_1) { conv_matrix_item(w1, 1024, 5632, F.W1, 1, r, scr, F.lane); continue; } r -= I_1;
        if (r < I_2) { conv_matrix_item(w2, FF, 1024, F.W2, 0, r, scr, F.lane); continue; } r -= I_2;
        if (r < I_IN) { conv_matrix_item(F.in[I_WIN] + (size_t)l * 1024 * NIN, 1024, NIN, F.WIN, 0, r, scr, F.lane); continue; } r -= I_IN;
        if (r < 4 * I_B) { const int m = r / I_B; conv_matrix_item(F.in[I_WBR] + ((size_t)(l * 4 + m)) * 256 * 1024, 256, 1024, F.WB + (size_t)m * 1024 * 256, 0, r % I_B, scr, F.lane); continue; } r -= 4 * I_B;
        conv_matrix_item(F.in[I_WOUT] + (size_t)l * 1024 * 1024, 1024, 1024, F.WO, 0, r, scr, F.lane);
    }
}

struct CvArgs { const float* W; int Nsrc, srccol0, nvalid, k0; bf16* WT; int ldd, n0; };
__device__ __forceinline__ CvArgs cv_matrix(const float* W, int K, int Nsrc, bf16* WT, int mode, int item) {
    const int nnb = ((Nsrc + 255) >> 8) * 8, nb = item % nnb, kb = item / nnb, n0 = nb * 32;
    CvArgs a; a.W = W; a.Nsrc = Nsrc; a.k0 = kb * 64; a.WT = WT; a.ldd = K; a.n0 = n0;
    if (mode == 0) { a.srccol0 = n0; int nv = Nsrc - n0; a.nvalid = nv < 0 ? 0 : (nv > 32 ? 32 : nv); }
    else { const int pn = n0 >> 8, rem = n0 & 255, bj = rem >> 7, jj = rem & 127; a.srccol0 = bj * FF + 128 * pn + jj; a.nvalid = 32; }
    return a;
}
__device__ __forceinline__ void cv_load(const CvArgs& a, int lane, f32x4 (&v)[8]) {
    const int rr = lane >> 3, ch = lane & 7;
    if (a.nvalid == 32 && ((a.Nsrc | a.srccol0) & 3) == 0) {
#pragma unroll
        for (int i = 0; i < 8; ++i) v[i] = __builtin_nontemporal_load((const f32x4*)(a.W + (size_t)(a.k0 + 8 * i + rr) * a.Nsrc + a.srccol0 + 4 * ch));
    } else {
#pragma unroll
        for (int i = 0; i < 8; ++i) { const float* p = a.W + (size_t)(a.k0 + 8 * i + rr) * a.Nsrc + a.srccol0 + 4 * ch;
#pragma unroll
            for (int e = 0; e < 4; ++e) v[i][e] = (4 * ch + e < a.nvalid) ? p[e] : 0.f; }
    }
}
__device__ __forceinline__ void cv_store(const CvArgs& a, LAS float* scr, int lane, const f32x4 (&v)[8]) {
    const int rr = lane >> 3, ch = lane & 7;
    const __amdgpu_buffer_rsrc_t wrs = __builtin_amdgcn_make_buffer_rsrc((void*)a.WT, 0, 0x7FFFFFFF, 0x00020000);
#pragma unroll
    for (int i = 0; i < 8; ++i) { LAS float* s = scr + (8 * i + rr) * 33 + 4 * ch; s[0] = v[i].x; s[1] = v[i].y; s[2] = v[i].z; s[3] = v[i].w; }
    LDS_WAIT(); asm volatile("" ::: "memory");
    const int c = lane & 7;
#pragma unroll
    for (int jj = 0; jj < 4; ++jj) { const int n = (lane >> 3) + 8 * jj; const LAS float* s = scr + (8 * c) * 33 + n;
        u32x4 o; o.x = cvtpk(s[0 * 33], s[1 * 33]); o.y = cvtpk(s[2 * 33], s[3 * 33]); o.z = cvtpk(s[4 * 33], s[5 * 33]); o.w = cvtpk(s[6 * 33], s[7 * 33]);
        __builtin_amdgcn_raw_buffer_store_b128(o, wrs, (unsigned)(((a.n0 + n) * a.ldd + a.k0 + 8 * c) * 2), 0,   16); }
    LDS_WAIT(); asm volatile("" ::: "memory");
}
__device__ __forceinline__ int cv_total(int what) {
    constexpr int I_1 = 16 * 176, I_2 = 44 * 32, I_IN = 16 * 240, I_B = 4 * 32, I_O = 16 * 32;
    return what == 0 ? I_1 + I_2 : what == 1 ? I_1 + I_2 + I_IN + 4 * I_B + I_O : what == 2 ? I_IN + 4 * I_B : I_1 + I_2 + I_O;
}
__device__ __forceinline__ CvArgs cv_decode(Frame& F, int l, int what, int it) {
    constexpr int I_1 = 16 * 176, I_2 = 44 * 32, I_IN = 16 * 240, I_B = 4 * 32;
    bf16* W1b = (bf16*)(F.ws + WS_P); bf16* W2b = (bf16*)(F.ws + WS_P + 11 * MiB);
    int r = it;
    if (what == 0) {
        if (r < I_1) return cv_matrix(F.in[I_FW1] + ((size_t)(l * 2 + 1)) * 1024 * 5632, 1024, 5632, F.W1, 1, r);
        return cv_matrix(F.in[I_FW2] + ((size_t)(l * 2 + 1)) * FF * 1024, FF, 1024, F.W2, 0, r - I_1);
    }
    if (what != 2) {
        if (r < I_1) return cv_matrix(F.in[I_FW1] + ((size_t)(l * 2)) * 1024 * 5632, 1024, 5632, W1b, 1, r); r -= I_1;
        if (r < I_2) return cv_matrix(F.in[I_FW2] + ((size_t)(l * 2)) * FF * 1024, FF, 1024, W2b, 0, r); r -= I_2;
    }
    if (what != 3) {
        if (r < I_IN) return cv_matrix(F.in[I_WIN] + (size_t)l * 1024 * NIN, 1024, NIN, F.WIN, 0, r); r -= I_IN;
        if (r < 4 * I_B) { const int m = r / I_B; return cv_matrix(F.in[I_WBR] + ((size_t)(l * 4 + m)) * 256 * 1024, 256, 1024, F.WB + (size_t)m * 1024 * 256, 0, r % I_B); } r -= 4 * I_B;
    }
    return cv_matrix(F.in[I_WOUT] + (size_t)l * 1024 * 1024, 1024, 1024, F.WO, 0, r);
}
__device__ __forceinline__ void conv_stride(Frame& F, int l, int what, int w, int stride) {
    LAS float* scr = (LAS float*)(F.lds + F.wave * 16384);
    const int total = cv_total(what);
    if (w >= total) return;
    CvArgs aA = cv_decode(F, l, what, w), aB = aA; f32x4 vA[8], vB[8]; cv_load(aA, F.lane, vA);
    int it = w;
    for (;;) {
        int nx = it + stride;
        if (nx < total) { aB = cv_decode(F, l, what, nx); cv_load(aB, F.lane, vB); }
        cv_store(aA, scr, F.lane, vA);
        if (nx >= total) break;
        it = nx; nx = it + stride;
        if (nx < total) { aA = cv_decode(F, l, what, nx); cv_load(aA, F.lane, vA); }
        cv_store(aB, scr, F.lane, vB);
        if (nx >= total) break;
        it = nx;
    }
}
__device__ __forceinline__ void conv_idle(Frame& F, int l, int what, int mode) {
    if (F.G != 256) { conv_stride(F, l, what, F.bid * 8 + F.wave, F.G * 8); return; }
    if (mode == 0) { if (F.bid >= 192) conv_stride(F, l, what, (F.bid - 192) * 8 + F.wave, 512); return; }
    if (F.bid < 32) conv_stride(F, l, what, F.bid * 8 + F.wave, 768);
    else if (F.bid < 64) { const int s0 = 256 + (F.bid - 32) * 16 + F.wave * 2; conv_stride(F, l, what, s0, 768); conv_stride(F, l, what, s0 + 1, 768); }
}

__device__ __forceinline__ void mod_item(Frame& F, int item) {
    LAS float* sc = (LAS float*)F.lds;
    LAS float* red = (LAS float*)(F.lds + 36864);
    const int l = item / 36, g = item % 36, col = 256 * g + 4 * F.lane;
    const float* W = F.in[I_WMOD] + (size_t)l * 1024 * 9216 + col;
    f32x4 acc[9];
#pragma unroll
    for (int c = 0; c < 9; ++c) acc[c] = (f32x4){0.f, 0.f, 0.f, 0.f};
    f32x4 wA[8], wB[8];
#define MOD_LOAD(w_, kb_) do { const int k0_ = F.wave * 128 + (kb_) * 8; _Pragma("unroll") for (int i = 0; i < 8; ++i) w_[i] = __builtin_nontemporal_load((const f32x4*)(W + (size_t)(k0_ + i) * 9216)); } while (0)
#define MOD_FMA(w_, kb_) do { const int k0_ = F.wave * 128 + (kb_) * 8; _Pragma("unroll") for (int i = 0; i < 8; ++i) _Pragma("unroll") for (int c = 0; c < 9; ++c) acc[c] += w_[i] * sc[c * 1024 + k0_ + i]; __builtin_amdgcn_sched_barrier(0); } while (0)
    MOD_LOAD(wA, 0);
#pragma unroll 1
    for (int kb = 0; kb < 16; kb += 2) {
        MOD_LOAD(wB, kb + 1); __builtin_amdgcn_sched_barrier(0);
        MOD_FMA(wA, kb);
        if (kb + 2 < 16) MOD_LOAD(wA, kb + 2);
        __builtin_amdgcn_sched_barrier(0);
        MOD_FMA(wB, kb + 1);
    }
#undef MOD_LOAD
#undef MOD_FMA
#pragma unroll
    for (int c = 0; c < 9; ++c) *(LAS f32x4*)(red + (F.wave * 9 + c) * 256 + 4 * F.lane) = acc[c];
    __syncthreads();
    for (int idx = F.tid; idx < 9 * 256; idx += 512) { const int c = idx >> 8, j = idx & 255; float s = 0.f;
#pragma unroll
        for (int w = 0; w < 8; ++w) s += red[(w * 9 + c) * 256 + j];
        F.MOD[(size_t)(l * 9 + c) * 9216 + 256 * g + j] = s + F.in[I_BMOD][l * 9216 + 256 * g + j]; }
    __syncthreads();
}
__device__ __forceinline__ void phase0(Frame& F) {
    const bool split = F.G >= 144;
    if (!split || F.bid < 72) {
        LAS float* sc = (LAS float*)F.lds;
        for (int idx = F.tid; idx < 9 * 1024; idx += 512) { const int c = idx >> 10, k = idx & 1023; const float v = (c == 0) ? F.in[I_CCTX][k] : F.in[I_C][(c - 1) * 1024 + k]; sc[idx] = siluf(v); }
        __syncthreads();
        for (int item = F.bid; item < 72; item += F.G) mod_item(F, item);
    }
    if (split) { if (F.bid >= 72) conv_stride(F, 0, 1, (F.bid - 72) * 8 + F.wave, (F.G - 72) * 8); }
    else { __syncthreads(); conv_stride(F, 0, 1, F.bid * 8 + F.wave, F.G * 8); }
}

__device__ __forceinline__ int cond_of_row(int row) { return row < MC ? 0 : 1 + ((row - MC) >> 10); }
__device__ __forceinline__ void norm_phase(Frame& F, int l, int i, bool srcX, bool final_) {
    const int gw = F.bid * 8 + F.wave, NGW = F.G * 8;
    const float* g = final_ ? F.in[I_FNG] : F.in[I_NG] + (l * 3 + i) * 1024;
    for (int row = gw; row < M; row += NGW) {
        const float* xr = srcX ? F.X + (size_t)row * D : (row < MC ? F.in[I_XP] + (size_t)row * D : F.in[I_XS] + (size_t)(row - MC) * D);
        f32x4 v[4]; float ss = 0.f;
#pragma unroll
        for (int j = 0; j < 4; ++j) { v[j] = *(const f32x4*)(xr + 4 * F.lane + 256 * j); ss += (v[j].x * v[j].x + v[j].y * v[j].y) + (v[j].z * v[j].z + v[j].w * v[j].w); }
        const float rstd = rsqrtf(wave_sum(ss) * (1.f / 1024.f) + 1e-6f);
        if (final_) {
#pragma unroll
            for (int j = 0; j < 4; ++j) { const f32x4 gg = *(const f32x4*)(g + 4 * F.lane + 256 * j); *(f32x4*)(F.X + (size_t)row * D + 4 * F.lane + 256 * j) = v[j] * rstd * gg; }
        } else {
            const float* mp = F.MOD + (size_t)(l * 9 + cond_of_row(row)) * 9216 + (3 * i) * 1024;
#pragma unroll
            for (int j = 0; j < 4; ++j) { const int c = 4 * F.lane + 256 * j; const f32x4 gg = *(const f32x4*)(g + c), sh = *(const f32x4*)(mp + c), scl = *(const f32x4*)(mp + 1024 + c);
                const f32x4 o = v[j] * rstd * gg * (scl + 1.f) + sh; st_bf4(F.XN + (size_t)row * D + c, o); }
        }
    }
}

__device__ __forceinline__ void row_geom(int row, int& s, int& t, int& T) { if (row < MC) { s = row >> 8; t = row & 255; T = 256; } else { s = 16 + ((row - MC) >> 10); t = (row - MC) & 1023; T = 1024; } }
__device__ __forceinline__ int seq_row0(int s) { return s < 16 ? s * 256 : MC + (s - 16) * 1024; }
__device__ __forceinline__ int kv_row(int s, int kvh) { return s < 16 ? (s * 2 + kvh) * 256 : 8192 + ((s - 16) * 2 + kvh) * 1280; }
__device__ __forceinline__ f32x4 shift4(const bf16* P, const float* mu, int row, int col, bool hasp, bool hasn) {
    const f32x4 p = ld_bf4(P + (size_t)row * NP + col);
    const f32x4 z = (f32x4){0.f, 0.f, 0.f, 0.f};
    const f32x4 pp = hasp ? ld_bf4(P + (size_t)(row - 1) * NP + col) : z;
    const f32x4 pn = hasn ? ld_bf4(P + (size_t)(row + 1) * NP + col) : z;
    const f32x4 m = *(const f32x4*)(mu + col);
    return p + m * ((pp + pn) * 0.5f - p);
}
__device__ __forceinline__ float shift1(const bf16* P, const float* mu, int row, int col, bool hasp, bool hasn) {
    const float p = bf2f(P[(size_t)row * NP + col]);
    const float pp = hasp ? bf2f(P[(size_t)(row - 1) * NP + col]) : 0.f;
    const float pn = hasn ? bf2f(P[(size_t)(row + 1) * NP + col]) : 0.f;
    return p + mu[col] * (0.5f * (pp + pn) - p);
}

__device__ __forceinline__ float sum4q(f32x4 v) { return (v.x * v.x + v.y * v.y) + (v.z * v.z + v.w * v.w); }
__device__ __forceinline__ float swz_xor4(float v) { return __int_as_float(__builtin_amdgcn_ds_swizzle(__float_as_int(v), 0x101F)); }
__device__ __forceinline__ void pre_phase(Frame& F, int l) {
    const int gw = F.bid * 8 + F.wave, NGW = F.G * 8, lane = F.lane;
    bf16* LI = F.XN;
    {
        const float* mu = F.in[I_MU] + l * 1184 + 768 + 8 * lane;
        f32x4 m0 = (f32x4){0.f, 0.f, 0.f, 0.f}, m1 = m0;
        if (lane < 52) { m0 = *(const f32x4*)mu; m1 = *(const f32x4*)(mu + 4); }
        for (int rowb = gw; rowb < M; rowb += 3 * NGW) {
            u32x2 w[3][6]; bool ok[3];
#pragma unroll
            for (int q = 0; q < 3; ++q) {
                const int row = rowb + q * NGW; ok[q] = row < M;
#pragma unroll
                for (int j = 0; j < 6; ++j) w[q][j] = (u32x2){0u, 0u};
                if (ok[q] && lane < 52) {
                    int s, t, T; row_geom(row, s, t, T);
                    const bf16* p = F.P + (size_t)row * NP + 768 + 8 * lane;
                    w[q][0] = *(const u32x2*)p; w[q][1] = *(const u32x2*)(p + 4);
                    if (t > 0) { w[q][2] = *(const u32x2*)(p - NP); w[q][3] = *(const u32x2*)(p - NP + 4); }
                    if (t < T - 1) { w[q][4] = *(const u32x2*)(p + NP); w[q][5] = *(const u32x2*)(p + NP + 4); }
                }
            }
#pragma unroll
            for (int q = 0; q < 3; ++q) {
                if (!ok[q]) continue;
                const int row = rowb + q * NGW;
                u32x4 o = (u32x4){0u, 0u, 0u, 0u};
                if (lane < 52) {
                    const f32x4 c0 = unbf4_(w[q][0]), c1 = unbf4_(w[q][1]), p0 = unbf4_(w[q][2]), p1 = unbf4_(w[q][3]), n0 = unbf4_(w[q][4]), n1 = unbf4_(w[q][5]);
                    f32x4 x0 = c0 + m0 * ((p0 + n0) * 0.5f - c0), x1 = c1 + m1 * ((p1 + n1) * 0.5f - c1);
                    if (lane < 16) { x0 = (f32x4){tanhf_(x0.x), tanhf_(x0.y), tanhf_(x0.z), tanhf_(x0.w)}; x1 = (f32x4){tanhf_(x1.x), tanhf_(x1.y), tanhf_(x1.z), tanhf_(x1.w)}; }
                    else if (lane >= 32) { x0 = (f32x4){sigm(x0.x), sigm(x0.y), sigm(x0.z), sigm(x0.w)}; x1 = (f32x4){sigm(x1.x), sigm(x1.y), sigm(x1.z), sigm(x1.w)}; }
                    o.x = cvtpk(x0.x, x0.y); o.y = cvtpk(x0.z, x0.w); o.z = cvtpk(x1.x, x1.y); o.w = cvtpk(x1.z, x1.w);
                }
                *(u32x4*)(LI + (size_t)row * 512 + 8 * lane) = o;
            }
        }
    }
    {
        const int d4 = 4 * (lane & 15);
        const f32x4 qg = *(const f32x4*)(F.in[I_QN] + l * 64 + d4), kg = *(const f32x4*)(F.in[I_KN] + l * 64 + d4);
        f32x4 invf;
#pragma unroll
        for (int e = 0; e < 4; ++e) invf[e] = __builtin_amdgcn_exp2f(-(float)((d4 + e) & 15) * 0.83048202372f) * 0.15915494309f;
        for (int grp = gw; grp < M / 8 + 256; grp += NGW) {
            if (grp < M / 8) {
                const int rowb = grp * 8; int s, tb, T; row_geom(rowb, s, tb, T);
                const bool lat = rowb >= MC; const int koff = lat ? 256 : 0, L = lat ? 1280 : 256;
                const int kvh = (lane >> 4) & 1;
                u32x2 vraw[8];
#pragma unroll
                for (int j = 0; j < 8; ++j) {
                    const int row = rowb + j, t = tb + j;
                    f32x4 cs = (f32x4){1.f, 1.f, 1.f, 1.f}, sn = (f32x4){0.f, 0.f, 0.f, 0.f};
                    if (lat) { const float pos = (float)(((lane & 15) < 8) ? (t >> 6) : (t & 63));
#pragma unroll
                        for (int e = 0; e < 4; ++e) { const float rev = pos * invf[e]; sn[e] = __builtin_amdgcn_sinf(rev); cs[e] = __builtin_amdgcn_cosf(rev); } }
                    {
                        const f32x4 x = ld_bf4(F.P + (size_t)row * NP + PD + 4 * lane);
                        const float ss = row16_sum(sum4q(x));
                        f32x4 y = x * rsqrtf(ss * (1.f / 64.f) + 1e-6f) * qg;
                        if (lat) { f32x4 pr; pr.x = swz_xor4(y.x); pr.y = swz_xor4(y.y); pr.z = swz_xor4(y.z); pr.w = swz_xor4(y.w); y = (lane & 4) ? (y * cs + pr * sn) : (y * cs - pr * sn); }
                        st_bf4(F.QN + (size_t)row * 256 + 4 * lane, y * 0.18033688011f);
                    }
                    {
                        const u32x2 raw = *(const u32x2*)(F.P + (size_t)row * NP + PD + 256 + 4 * lane);
                        vraw[j] = raw;
                        f32x4 x; x.x = __uint_as_float(raw.x << 16); x.y = __uint_as_float(raw.x & 0xffff0000u); x.z = __uint_as_float(raw.y << 16); x.w = __uint_as_float(raw.y & 0xffff0000u);
                        const float ss = row16_sum(sum4q(x));
                        f32x4 y = x * rsqrtf(ss * (1.f / 64.f) + 1e-6f) * kg;
                        if (lane < 32) {
                            if (!lat) *(f32x4*)(F.out + O_CK + ((((size_t)s * 2 + l) * 256 + t) * 2 + kvh) * 64 + d4) = y;
                        } else {
                            if (!lat) *(f32x4*)(F.out + O_CV + ((((size_t)s * 2 + l) * 256 + t) * 2 + kvh) * 64 + d4) = x;
                        }
                        if (lat) { f32x4 pr; pr.x = swz_xor4(y.x); pr.y = swz_xor4(y.y); pr.z = swz_xor4(y.z); pr.w = swz_xor4(y.w); y = (lane & 4) ? (y * cs + pr * sn) : (y * cs - pr * sn); }
                        if (lane < 32) st_bf4(F.KN + (size_t)(kv_row(s, kvh) + koff + t) * 64 + d4, y);
                    }
                }
                if (lane >= 32) {
                    bf16* vb = F.VT + (size_t)kv_row(s, kvh) * 64 + koff + tb;
#pragma unroll
                    for (int e = 0; e < 4; ++e) {
                        u32x4 w;
                        if (e == 0) { w.x = (vraw[0].x & 0xffffu) | (vraw[1].x << 16); w.y = (vraw[2].x & 0xffffu) | (vraw[3].x << 16); w.z = (vraw[4].x & 0xffffu) | (vraw[5].x << 16); w.w = (vraw[6].x & 0xffffu) | (vraw[7].x << 16); }
                        else if (e == 1) { w.x = (vraw[0].x >> 16) | (vraw[1].x & 0xffff0000u); w.y = (vraw[2].x >> 16) | (vraw[3].x & 0xffff0000u); w.z = (vraw[4].x >> 16) | (vraw[5].x & 0xffff0000u); w.w = (vraw[6].x >> 16) | (vraw[7].x & 0xffff0000u); }
                        else if (e == 2) { w.x = (vraw[0].y & 0xffffu) | (vraw[1].y << 16); w.y = (vraw[2].y & 0xffffu) | (vraw[3].y << 16); w.z = (vraw[4].y & 0xffffu) | (vraw[5].y << 16); w.w = (vraw[6].y & 0xffffu) | (vraw[7].y << 16); }
                        else { w.x = (vraw[0].y >> 16) | (vraw[1].y & 0xffff0000u); w.y = (vraw[2].y >> 16) | (vraw[3].y & 0xffff0000u); w.z = (vraw[4].y >> 16) | (vraw[5].y & 0xffff0000u); w.w = (vraw[6].y >> 16) | (vraw[7].y & 0xffff0000u); }
                        *(u32x4*)(vb + (size_t)(d4 + e) * L) = w;
                    }
                }
            } else {
                const int cg8 = grp - M / 8, b = cg8 >> 5, jb = (cg8 & 31) * 8, kvh = (lane >> 4) & 1;
                f32x4 xv[8];
#pragma unroll
                for (int j = 0; j < 8; ++j) {
                    const size_t src = ((((size_t)b * 2 + l) * 256 + jb + j) * 2 + kvh) * 64 + d4;
                    xv[j] = (lane < 32) ? *(const f32x4*)(F.in[I_CK] + src) : *(const f32x4*)(F.in[I_CV] + src);
                    if (lane < 32) st_bf4(F.KN + (size_t)(kv_row(16 + b, kvh) + jb + j) * 64 + d4, xv[j]);
                }
                if (lane >= 32) {
                    bf16* vb = F.VT + (size_t)kv_row(16 + b, kvh) * 64 + jb;
#pragma unroll
                    for (int e = 0; e < 4; ++e) { u32x4 w; w.x = pk2(xv[0][e], xv[1][e]); w.y = pk2(xv[2][e], xv[3][e]); w.z = pk2(xv[4][e], xv[5][e]); w.w = pk2(xv[6][e], xv[7][e]);
                        *(u32x4*)(vb + (size_t)(d4 + e) * 1280) = w; }
                }
            }
        }
    }
    {
        bf16* WL = (bf16*)(F.ws + WS_WL);
        for (int idx = (F.bid * 512 + F.tid) * 2; idx < 1280 * 512; idx += F.G * 1024) {
            const int n = idx >> 9, k = idx & 511, blk = n >> 8, nn = n & 255;
            float v0 = 0.f, v1 = 0.f;
            if (blk < 4) { const int k0 = blk * 64; const float* W = ((blk < 2) ? F.in[I_WUP] : F.in[I_AUP]) + (size_t)(l * 2 + (blk & 1)) * 64 * 256;
                if (k >= k0 && k < k0 + 64) { v0 = W[(size_t)(k - k0) * 256 + nn]; v1 = W[(size_t)(k + 1 - k0) * 256 + nn]; } }
            else { const float* W = F.in[I_GUP] + (size_t)l * 160 * 256; if (k >= 256 && k < 416) { v0 = W[(size_t)(k - 256) * 256 + nn]; v1 = W[(size_t)(k - 255) * 256 + nn]; } }
            *(unsigned*)(WL + idx) = pk2(v0, v1);
        }
    }
}

constexpr int OPSZ = 2048, BUFSZ = 6 * OPSZ;
__device__ __forceinline__ float red8(float v) { v += DPPF(v, 0xB1); v += DPPF(v, 0x4E); v += DPPF(v, 0x141); return v; }
__device__ __forceinline__ f32x2 fma2(f32x2 a, f32x2 b, f32x2 c) { return __builtin_elementwise_fma(a, b, c); }


struct OpsR { f32x4 wa, wb, ka, kb, aa, ab, da, db, ra, rb; f32x2 val; };
__device__ __forceinline__ void ld_rwkv(OpsR& o, const LAS float* op, int ti, int seg, int rp) {
    const LAS float* pb = op + ti * 64 + 8 * seg;
    o.wa = *(const LAS f32x4*)(pb); o.wb = *(const LAS f32x4*)(pb + 4);
    o.ka = *(const LAS f32x4*)(pb + OPSZ); o.kb = *(const LAS f32x4*)(pb + OPSZ + 4);
    o.aa = *(const LAS f32x4*)(pb + 2 * OPSZ); o.ab = *(const LAS f32x4*)(pb + 2 * OPSZ + 4);
    o.da = *(const LAS f32x4*)(pb + 3 * OPSZ); o.db = *(const LAS f32x4*)(pb + 3 * OPSZ + 4);
    o.ra = *(const LAS f32x4*)(pb + 4 * OPSZ); o.rb = *(const LAS f32x4*)(pb + 4 * OPSZ + 4);
    o.val = *(const LAS f32x2*)(op + 5 * OPSZ + ti * 64 + 2 * rp);
}
__device__ __forceinline__ void step_rwkv(f32x2 (&S2)[2][4], const OpsR& o, LAS float* ydst) {
    const f32x2 w2[4] = {o.wa.xy, o.wa.zw, o.wb.xy, o.wb.zw}, kk2[4] = {o.ka.xy, o.ka.zw, o.kb.xy, o.kb.zw}, kka2[4] = {o.aa.xy, o.aa.zw, o.ab.xy, o.ab.zw},
                kd2[4] = {o.da.xy, o.da.zw, o.db.xy, o.db.zw}, r2[4] = {o.ra.xy, o.ra.zw, o.rb.xy, o.rb.zw};
    f32x2 d0 = S2[0][0] * kk2[0], d1 = S2[1][0] * kk2[0];
#pragma unroll
    for (int j = 1; j < 4; ++j) { d0 = fma2(S2[0][j], kk2[j], d0); d1 = fma2(S2[1][j], kk2[j], d1); }
    const float sa0 = -red8(d0.x + d0.y), sa1 = -red8(d1.x + d1.y);
    const f32x2 sa0v = (f32x2){sa0, sa0}, sa1v = (f32x2){sa1, sa1}, v0v = (f32x2){o.val.x, o.val.x}, v1v = (f32x2){o.val.y, o.val.y};
    f32x2 y0 = (f32x2){0.f, 0.f}, y1 = (f32x2){0.f, 0.f};
#pragma unroll
    for (int j = 0; j < 4; ++j) {
        const f32x2 t0 = fma2(sa0v, kka2[j], v0v * kd2[j]), t1 = fma2(sa1v, kka2[j], v1v * kd2[j]);
        S2[0][j] = fma2(S2[0][j], w2[j], t0); S2[1][j] = fma2(S2[1][j], w2[j], t1);
        y0 = fma2(S2[0][j], r2[j], y0); y1 = fma2(S2[1][j], r2[j], y1);
    }
    const float yy0 = red8(y0.x + y0.y), yy1 = red8(y1.x + y1.y);
    *(LAS f32x2*)ydst = (f32x2){yy0, yy1};
}
struct OpsD { f32x4 ka, kb, qa, qb; f32x2 val, eb; };
__device__ __forceinline__ void ld_delta(OpsD& o, const LAS float* op, const LAS float* scal, int ti, int seg, int rp) {
    const LAS float* pb = op + ti * 64 + 8 * seg;
    o.ka = *(const LAS f32x4*)(pb); o.kb = *(const LAS f32x4*)(pb + 4);
    o.qa = *(const LAS f32x4*)(pb + OPSZ); o.qb = *(const LAS f32x4*)(pb + OPSZ + 4);
    o.val = *(const LAS f32x2*)(op + 2 * OPSZ + ti * 64 + 2 * rp);
    o.eb = *(const LAS f32x2*)(scal + ti * 2);
}
__device__ __forceinline__ void step_delta(f32x2 (&S2)[2][4], const OpsD& o, LAS float* ydst) {
    const f32x2 k2[4] = {o.ka.xy, o.ka.zw, o.kb.xy, o.kb.zw}, q2[4] = {o.qa.xy, o.qa.zw, o.qb.xy, o.qb.zw};
    f32x2 d0 = S2[0][0] * k2[0], d1 = S2[1][0] * k2[0];
#pragma unroll
    for (int j = 1; j < 4; ++j) { d0 = fma2(S2[0][j], k2[j], d0); d1 = fma2(S2[1][j], k2[j], d1); }
    const float kS0 = red8(d0.x + d0.y), kS1 = red8(d1.x + d1.y);
    const float vn0 = o.eb.y * (o.val.x - o.eb.x * kS0), vn1 = o.eb.y * (o.val.y - o.eb.x * kS1);
    const f32x2 vn0v = (f32x2){vn0, vn0}, vn1v = (f32x2){vn1, vn1}, egv = (f32x2){o.eb.x, o.eb.x};
    f32x2 y0 = (f32x2){0.f, 0.f}, y1 = (f32x2){0.f, 0.f};
#pragma unroll
    for (int j = 0; j < 4; ++j) {
        S2[0][j] = fma2(S2[0][j], egv, k2[j] * vn0v); S2[1][j] = fma2(S2[1][j], egv, k2[j] * vn1v);
        y0 = fma2(S2[0][j], q2[j], y0); y1 = fma2(S2[1][j], q2[j], y1);
    }
    const float yy0 = red8(y0.x + y0.y), yy1 = red8(y1.x + y1.y);
    *(LAS f32x2*)ydst = (f32x2){yy0, yy1};
}
struct OpsG { f32x4 aa, ab, ka, kb, qa, qb; float val; };
__device__ __forceinline__ void ld_gla(OpsG& o, const LAS float* op, int ti, int seg, int rp) {
    const LAS float* pb = op + ti * 32 + 8 * seg;
    o.aa = *(const LAS f32x4*)(pb); o.ab = *(const LAS f32x4*)(pb + 4);
    o.ka = *(const LAS f32x4*)(pb + OPSZ); o.kb = *(const LAS f32x4*)(pb + OPSZ + 4);
    o.qa = *(const LAS f32x4*)(pb + 2 * OPSZ); o.qb = *(const LAS f32x4*)(pb + 2 * OPSZ + 4);
    o.val = op[3 * OPSZ + ti * 64 + rp];
}
__device__ __forceinline__ void step_gla(f32x2 (&S)[4], const OpsG& o, LAS float* ydst) {
    const f32x2 a2[4] = {o.aa.xy, o.aa.zw, o.ab.xy, o.ab.zw}, k2[4] = {o.ka.xy, o.ka.zw, o.kb.xy, o.kb.zw}, q2[4] = {o.qa.xy, o.qa.zw, o.qb.xy, o.qb.zw};
    const f32x2 vv = (f32x2){o.val, o.val};
    f32x2 y0 = (f32x2){0.f, 0.f};
#pragma unroll
    for (int j = 0; j < 4; ++j) { S[j] = fma2(S[j], a2[j], k2[j] * vv); y0 = fma2(S[j], q2[j], y0); }
    *ydst = quad_sum(y0.x + y0.y);
}

template <int MIX>
__device__ __forceinline__ void stage_chunk(Frame& F, int l, int dir, int h, int row0, int T, int tbase, LAS float* op, LAS float* scal, int st) {
    const int stok = st >> 3, sq = st & 7;
    const int t = tbase + stok, row = row0 + t; const bool hasp = t > 0, hasn = t < T - 1;
    if (MIX == 0) {
        const float* mu = F.in[I_MU] + l * 1184;
        f32x4 r4[2], k4[2], v4[2], E4[2], a4[2], kk4[2]; float ss = 0.f;
#pragma unroll
        for (int g = 0; g < 2; ++g) {
            const int c = h * 64 + 8 * sq + 4 * g;
            r4[g] = shift4(F.P, mu, row, PA + c, hasp, hasn); k4[g] = shift4(F.P, mu, row, PA + 256 + c, hasp, hasn); v4[g] = shift4(F.P, mu, row, PA + 512 + c, hasp, hasn);
            E4[g] = ld_bf4(F.FEAT + (size_t)row * NFEAT + dir * 256 + c); a4[g] = ld_bf4(F.FEAT + (size_t)row * NFEAT + 512 + dir * 256 + c);
            kk4[g] = k4[g] * *(const f32x4*)(F.in[I_KK] + l * 256 + c);
            ss += (kk4[g].x * kk4[g].x + kk4[g].y * kk4[g].y) + (kk4[g].z * kk4[g].z + kk4[g].w * kk4[g].w);
        }
        const float rn = rsqrtf(red8(ss) + 1e-6f);
#pragma unroll
        for (int g = 0; g < 2; ++g) {
            const int c = h * 64 + 8 * sq + 4 * g;
            const f32x4 kaw = *(const f32x4*)(F.in[I_KA] + l * 256 + c);
            const f32x4 kkn = kk4[g] * rn;
            f32x4 w4; w4.x = __expf(-E4[g].x); w4.y = __expf(-E4[g].y); w4.z = __expf(-E4[g].z); w4.w = __expf(-E4[g].w);
            const f32x4 kd4 = k4[g] * ((a4[g] - 1.f) * kaw + 1.f), kka4 = kkn * a4[g];
            const int o = stok * 64 + 8 * sq + 4 * g;
            *(LAS f32x4*)(op + 0 * OPSZ + o) = w4; *(LAS f32x4*)(op + 1 * OPSZ + o) = kkn; *(LAS f32x4*)(op + 2 * OPSZ + o) = kka4;
            *(LAS f32x4*)(op + 3 * OPSZ + o) = kd4; *(LAS f32x4*)(op + 4 * OPSZ + o) = r4[g]; *(LAS f32x4*)(op + 5 * OPSZ + o) = v4[g];
        }
    } else if (MIX == 1) {
        const float* cw = F.in[I_DCV] + l * 3 * 768;
        f32x4 o3[2][3]; float sq_ = 0.f, sk_ = 0.f;
#pragma unroll
        for (int g = 0; g < 2; ++g) {
            const int c = h * 64 + 8 * sq + 4 * g;
#pragma unroll
            for (int part = 0; part < 3; ++part) {
                const int cc = part * 256 + c, col = PC + cc;
                const f32x4 z = (f32x4){0.f, 0.f, 0.f, 0.f};
                const f32x4 xm = hasp ? ld_bf4(F.P + (size_t)(row - 1) * NP + col) : z, x0 = ld_bf4(F.P + (size_t)row * NP + col), xp = hasn ? ld_bf4(F.P + (size_t)(row + 1) * NP + col) : z;
                const f32x4 y = xm * *(const f32x4*)(cw + cc) + x0 * *(const f32x4*)(cw + 768 + cc) + xp * *(const f32x4*)(cw + 1536 + cc);
                f32x4 sy; sy.x = siluf(y.x); sy.y = siluf(y.y); sy.z = siluf(y.z); sy.w = siluf(y.w);
                o3[g][part] = sy;
            }
            sq_ += (o3[g][0].x * o3[g][0].x + o3[g][0].y * o3[g][0].y) + (o3[g][0].z * o3[g][0].z + o3[g][0].w * o3[g][0].w);
            sk_ += (o3[g][1].x * o3[g][1].x + o3[g][1].y * o3[g][1].y) + (o3[g][1].z * o3[g][1].z + o3[g][1].w * o3[g][1].w);
        }
        const float qn = rsqrtf(red8(sq_) + 1e-6f) * 0.125f, kn = rsqrtf(red8(sk_) + 1e-6f);
#pragma unroll
        for (int g = 0; g < 2; ++g) {
            const int o = stok * 64 + 8 * sq + 4 * g;
            *(LAS f32x4*)(op + 0 * OPSZ + o) = o3[g][1] * kn; *(LAS f32x4*)(op + 1 * OPSZ + o) = o3[g][0] * qn; *(LAS f32x4*)(op + 2 * OPSZ + o) = o3[g][2];
        }
        if (sq == 0) {
            const float bd = bf2f(F.P[(size_t)row * NP + PC + 1024 + dir * 4 + h]), ad = bf2f(F.P[(size_t)row * NP + PC + 1032 + dir * 4 + h]);
            const float gg = -__expf(F.in[I_DAL][(l * 2 + dir) * 4 + h]) * softplusf(ad + F.in[I_DDT][(l * 2 + dir) * 4 + h]);
            scal[stok * 2] = __expf(gg); scal[stok * 2 + 1] = sigm(bd);
        }
    } else {
        const int kx = 4 * sq;
        const f32x4 q4 = ld_bf4(F.P + (size_t)row * NP + PB + h * 32 + kx) * 0.17677669529f;
        const f32x4 k4 = ld_bf4(F.P + (size_t)row * NP + PB + 128 + h * 32 + kx);
        const float* au = F.in[I_GAU] + (size_t)(l * 2 + dir) * 16 * 128 + h * 32 + kx;
        f32x4 x4 = *(const f32x4*)(F.in[I_GAB] + (l * 2 + dir) * 128 + h * 32 + kx);
        const f32x4 ad0 = ld_bf4(F.P + (size_t)row * NP + PB + 512 + dir * 16), ad1 = ld_bf4(F.P + (size_t)row * NP + PB + 512 + dir * 16 + 4), ad2 = ld_bf4(F.P + (size_t)row * NP + PB + 512 + dir * 16 + 8), ad3 = ld_bf4(F.P + (size_t)row * NP + PB + 512 + dir * 16 + 12);
#pragma unroll
        for (int j = 0; j < 4; ++j) { x4 += *(const f32x4*)(au + j * 128) * ad0[j]; x4 += *(const f32x4*)(au + (4 + j) * 128) * ad1[j]; x4 += *(const f32x4*)(au + (8 + j) * 128) * ad2[j]; x4 += *(const f32x4*)(au + (12 + j) * 128) * ad3[j]; }
        f32x4 a4; a4.x = __expf(-softplusf(-x4.x) * (1.f / 16.f)); a4.y = __expf(-softplusf(-x4.y) * (1.f / 16.f)); a4.z = __expf(-softplusf(-x4.z) * (1.f / 16.f)); a4.w = __expf(-softplusf(-x4.w) * (1.f / 16.f));
        const int o = stok * 32 + kx;
        *(LAS f32x4*)(op + 0 * OPSZ + o) = a4; *(LAS f32x4*)(op + 1 * OPSZ + o) = k4; *(LAS f32x4*)(op + 2 * OPSZ + o) = q4;
        *(LAS f32x4*)(op + 3 * OPSZ + stok * 64 + 8 * sq) = ld_bf4(F.P + (size_t)row * NP + PB + 256 + h * 64 + 8 * sq);
        *(LAS f32x4*)(op + 3 * OPSZ + stok * 64 + 8 * sq + 4) = ld_bf4(F.P + (size_t)row * NP + PB + 256 + h * 64 + 8 * sq + 4);
    }
}

template <int MIX  >
__device__ __forceinline__ void scan_item(Frame& F, int l, int s, int dir, int h) {
    LAS float* lds = (LAS float*)F.lds;
    const int T = s < 16 ? 256 : 1024, row0 = seq_row0(s), nch = T / 32, tid = F.tid;
    const bool scanner = F.wave < 4;
    const int L = tid & 255, st = tid & 255;
    const int seg = (MIX == 2) ? (L & 3) : (L & 7), rp = (MIX == 2) ? (L >> 2) : (L >> 3);
    f32x2 S2[2][4];
#pragma unroll
    for (int r = 0; r < 2; ++r)
#pragma unroll
        for (int j = 0; j < 4; ++j) S2[r][j] = (f32x2){0.f, 0.f};
    if (scanner && s >= 16) {
        const int b = s - 16;
        if (MIX == 0) {
#pragma unroll
            for (int r = 0; r < 2; ++r) { const float* sp = F.in[I_SR] + ((((size_t)(b * 2 + l) * 2 + dir) * 4 + h) * 64 + 2 * rp + r) * 64 + 8 * seg;
#pragma unroll
                for (int j = 0; j < 4; ++j) S2[r][j] = *(const f32x2*)(sp + 2 * j); }
        } else if (MIX == 1) {
            const float* sp = F.in[I_SD] + (((size_t)(b * 2 + l) * 2 + dir) * 4 + h) * 64 * 64 + 2 * rp;
#pragma unroll
            for (int j = 0; j < 4; ++j) { const f32x2 lo = *(const f32x2*)(sp + (size_t)(8 * seg + 2 * j) * 64), hi = *(const f32x2*)(sp + (size_t)(8 * seg + 2 * j + 1) * 64);
                S2[0][j] = (f32x2){lo.x, hi.x}; S2[1][j] = (f32x2){lo.y, hi.y}; }
        } else {
            const float* sp = F.in[I_SG] + (((size_t)(b * 2 + l) * 2 + dir) * 4 + h) * 32 * 64 + rp;
#pragma unroll
            for (int j = 0; j < 4; ++j) S2[0][j] = (f32x2){sp[(size_t)(8 * seg + 2 * j) * 64], sp[(size_t)(8 * seg + 2 * j + 1) * 64]};
        }
    }
    if (scanner) __builtin_amdgcn_s_setprio(2);
    if (!scanner) stage_chunk<MIX>(F, l, dir, h, row0, T, dir == 0 ? 0 : T - 32, lds, lds + 2 * BUFSZ + 2 * OPSZ, st);
    __syncthreads();
    for (int ci = 0; ci < nch; ++ci) {
        const int tbase = dir == 0 ? 32 * ci : T - 32 * (ci + 1);
        LAS float* op = lds + (ci & 1) * BUFSZ; LAS float* ybuf = lds + 2 * BUFSZ + (ci & 1) * OPSZ; LAS float* scal = lds + 2 * BUFSZ + 2 * OPSZ + 64 * (ci & 1);
        if (scanner) {
            LAS float* ydum = lds + 2 * BUFSZ + 2 * OPSZ + 128 + 2 * L;
            if (MIX == 0) {
                OpsR A, B; ld_rwkv(A, op, dir == 0 ? 0 : 31, seg, rp);
#pragma unroll 1
                for (int i = 0; i < 32; i += 2) {
                    const int t0 = dir == 0 ? i : 31 - i, t1 = dir == 0 ? i + 1 : 30 - i, i2 = i + 2 < 32 ? i + 2 : 31, t2 = dir == 0 ? i2 : 31 - i2;
                    ld_rwkv(B, op, t1, seg, rp);
                    step_rwkv(S2, A, seg == 0 ? ybuf + t0 * 64 + 2 * rp : ydum);
                    ld_rwkv(A, op, t2, seg, rp);
                    step_rwkv(S2, B, seg == 0 ? ybuf + t1 * 64 + 2 * rp : ydum);
                }
            } else if (MIX == 1) {
                OpsD A, B; ld_delta(A, op, scal, dir == 0 ? 0 : 31, seg, rp);
#pragma unroll 1
                for (int i = 0; i < 32; i += 2) {
                    const int t0 = dir == 0 ? i : 31 - i, t1 = dir == 0 ? i + 1 : 30 - i, i2 = i + 2 < 32 ? i + 2 : 31, t2 = dir == 0 ? i2 : 31 - i2;
                    ld_delta(B, op, scal, t1, seg, rp);
                    step_delta(S2, A, seg == 0 ? ybuf + t0 * 64 + 2 * rp : ydum);
                    ld_delta(A, op, scal, t2, seg, rp);
                    step_delta(S2, B, seg == 0 ? ybuf + t1 * 64 + 2 * rp : ydum);
                }
            } else {
                OpsG A, B; ld_gla(A, op, dir == 0 ? 0 : 31, seg, rp);
#pragma unroll 1
                for (int i = 0; i < 32; i += 2) {
                    const int t0 = dir == 0 ? i : 31 - i, t1 = dir == 0 ? i + 1 : 30 - i, i2 = i + 2 < 32 ? i + 2 : 31, t2 = dir == 0 ? i2 : 31 - i2;
                    ld_gla(B, op, t1, seg, rp);
                    step_gla(S2[0], A, seg == 0 ? ybuf + t0 * 64 + rp : ydum);
                    ld_gla(A, op, t2, seg, rp);
                    step_gla(S2[0], B, seg == 0 ? ybuf + t1 * 64 + rp : ydum);
                }
            }
        } else {
            if (ci + 1 < nch) stage_chunk<MIX>(F, l, dir, h, row0, T, dir == 0 ? 32 * (ci + 1) : T - 32 * (ci + 2), lds + ((ci + 1) & 1) * BUFSZ, lds + 2 * BUFSZ + 2 * OPSZ + 64 * ((ci + 1) & 1), st);
            if (ci > 0) {
                const int pt = dir == 0 ? 32 * (ci - 1) : T - 32 * ci; const LAS float* yb = lds + 2 * BUFSZ + ((ci - 1) & 1) * OPSZ;
                const int tok = st >> 3, c8 = (st & 7) * 8;
                bf16* yo = F.YP + ((size_t)(MIX * 2 + dir) * M + row0 + pt + tok) * 256 + h * 64 + c8;
                st_bf4(yo, *(const LAS f32x4*)(yb + tok * 64 + c8)); st_bf4(yo + 4, *(const LAS f32x4*)(yb + tok * 64 + c8 + 4));
            }
        }
        __syncthreads();
    }
    if (scanner) __builtin_amdgcn_s_setprio(0);
    if (!scanner) {
        const int pt = dir == 0 ? 32 * (nch - 1) : 0; const LAS float* yb = lds + 2 * BUFSZ + ((nch - 1) & 1) * OPSZ;
        const int tok = st >> 3, c8 = (st & 7) * 8;
        bf16* yo = F.YP + ((size_t)(MIX * 2 + dir) * M + row0 + pt + tok) * 256 + h * 64 + c8;
        st_bf4(yo, *(const LAS f32x4*)(yb + tok * 64 + c8)); st_bf4(yo + 4, *(const LAS f32x4*)(yb + tok * 64 + c8 + 4));
    } else if (s < 16) {
        if (MIX == 0) {
#pragma unroll
            for (int r = 0; r < 2; ++r) { float* sp = F.out + O_SR + ((((size_t)(s * 2 + l) * 2 + dir) * 4 + h) * 64 + 2 * rp + r) * 64 + 8 * seg;
#pragma unroll
                for (int j = 0; j < 4; ++j) *(f32x2*)(sp + 2 * j) = S2[r][j]; }
        } else if (MIX == 1) {
            float* sp = F.out + O_SD + (((size_t)(s * 2 + l) * 2 + dir) * 4 + h) * 64 * 64 + 2 * rp;
#pragma unroll
            for (int j = 0; j < 4; ++j) { *(f32x2*)(sp + (size_t)(8 * seg + 2 * j) * 64) = (f32x2){S2[0][j].x, S2[1][j].x}; *(f32x2*)(sp + (size_t)(8 * seg + 2 * j + 1) * 64) = (f32x2){S2[0][j].y, S2[1][j].y}; }
        } else {
            float* sp = F.out + O_SG + (((size_t)(s * 2 + l) * 2 + dir) * 4 + h) * 32 * 64 + rp;
#pragma unroll
            for (int j = 0; j < 4; ++j) { sp[(size_t)(8 * seg + 2 * j) * 64] = S2[0][j].x; sp[(size_t)(8 * seg + 2 * j + 1) * 64] = S2[0][j].y; }
        }
    }
    __syncthreads();
}

#define CH_BAR() do { asm volatile("s_waitcnt lgkmcnt(0)" ::: "memory"); __builtin_amdgcn_s_barrier(); asm volatile("" ::: "memory"); } while (0)
constexpr int AT_P = 72;
constexpr int AT_TILE = 64 * AT_P;
__device__ __forceinline__ void attn_tile_lds(const LAS bf16* Kt, const LAS bf16* Vt, int sub, const bf16x8 (&qf)[4], f32x16& O0, f32x16& O1, float& mrun, float& lsum, int lane) {
    const int r = lane & 31, hh = lane >> 5;
    f32x16 st;
#pragma unroll
    for (int e = 0; e < 16; ++e) st[e] = 0.f;
#pragma unroll
    for (int ks = 0; ks < 4; ++ks) { const bf16x8 kf = *(const LAS bf16x8*)(Kt + (32 * sub + r) * AT_P + 16 * ks + 8 * hh); st = __builtin_amdgcn_mfma_f32_32x32x16_bf16(kf, qf[ks], st, 0, 0, 0); }
    float tmax = st[0];
#pragma unroll
    for (int e = 1; e < 16; ++e) tmax = fmaxf(tmax, st[e]);
    tmax = fmaxf(tmax, xor32(tmax, lane));
    const float mnew = fmaxf(mrun, tmax), alpha = __builtin_amdgcn_exp2f(mrun - mnew);
    mrun = mnew;
    float ps = 0.f;
#pragma unroll
    for (int e = 0; e < 16; ++e) { st[e] = __builtin_amdgcn_exp2f(st[e] - mnew); ps += st[e]; }
    lsum = lsum * alpha + ps;
#pragma unroll
    for (int e = 0; e < 16; ++e) { O0[e] *= alpha; O1[e] *= alpha; }
#pragma unroll
    for (int sx = 0; sx < 2; ++sx) {
        u32x4 pw; pw.x = cvtpk(st[8 * sx + 0], st[8 * sx + 1]); pw.y = cvtpk(st[8 * sx + 2], st[8 * sx + 3]); pw.z = cvtpk(st[8 * sx + 4], st[8 * sx + 5]); pw.w = cvtpk(st[8 * sx + 6], st[8 * sx + 7]);
        const bf16x8 pb = __builtin_bit_cast(bf16x8, pw);
        const LAS bf16* vp0 = Vt + r * AT_P + 32 * sub + 16 * sx + 4 * hh; const LAS bf16* vp1 = vp0 + 32 * AT_P;
        const bf16x8 v0 = __builtin_shufflevector(*(const LAS s16x4*)vp0, *(const LAS s16x4*)(vp0 + 8), 0, 1, 2, 3, 4, 5, 6, 7);
        const bf16x8 v1 = __builtin_shufflevector(*(const LAS s16x4*)vp1, *(const LAS s16x4*)(vp1 + 8), 0, 1, 2, 3, 4, 5, 6, 7);
        O0 = __builtin_amdgcn_mfma_f32_32x32x16_bf16(v0, pb, O0, 0, 0, 0);
        O1 = __builtin_amdgcn_mfma_f32_32x32x16_bf16(v1, pb, O1, 0, 0, 0);
    }
}
__device__ __forceinline__ void attn_item(Frame& F, int s, int kvh, int qc) {
    const int lane = F.lane, tid = F.tid, r = lane & 31, hh = lane >> 5, h = 2 * kvh + (F.wave >> 2);
    const int L = s < 16 ? 256 : 1280, row0 = seq_row0(s), q0 = qc * 128 + (F.wave & 3) * 32;
    const bf16* Kb = F.KN + (size_t)kv_row(s, kvh) * 64;
    const bf16* Vb = F.VT + (size_t)kv_row(s, kvh) * 64;
    LAS bf16* lds = (LAS bf16*)F.lds;
    bf16x8 qf[4];
#pragma unroll
    for (int ks = 0; ks < 4; ++ks) qf[ks] = *(const bf16x8*)(F.QN + (size_t)(row0 + q0 + r) * 256 + h * 64 + 16 * ks + 8 * hh);
    f32x16 O0, O1;
#pragma unroll
    for (int e = 0; e < 16; ++e) { O0[e] = 0.f; O1[e] = 0.f; }
    float mrun = -1e30f, lsum = 0.f;
    const int srow = tid >> 3, sch = (tid & 7) * 8;
    u32x4 kreg = *(const u32x4*)(Kb + (size_t)srow * 64 + sch), vreg = *(const u32x4*)(Vb + (size_t)srow * L + sch);
    *(LAS u32x4*)(lds + srow * AT_P + sch) = kreg; *(LAS u32x4*)(lds + AT_TILE + srow * AT_P + sch) = vreg;
    CH_BAR();
    const int nt = L / 64;
#pragma unroll 1
    for (int j = 0; j < nt; ++j) {
        const int jn = j + 1 < nt ? j + 1 : j;
        kreg = *(const u32x4*)(Kb + (size_t)(64 * jn + srow) * 64 + sch); vreg = *(const u32x4*)(Vb + (size_t)srow * L + 64 * jn + sch);
        const LAS bf16* Kt = lds + (j & 1) * 2 * AT_TILE; const LAS bf16* Vt = Kt + AT_TILE;
        attn_tile_lds(Kt, Vt, 0, qf, O0, O1, mrun, lsum, lane);
        attn_tile_lds(Kt, Vt, 1, qf, O0, O1, mrun, lsum, lane);
        LAS bf16* Kn = lds + ((j + 1) & 1) * 2 * AT_TILE;
        *(LAS u32x4*)(Kn + srow * AT_P + sch) = kreg; *(LAS u32x4*)(Kn + AT_TILE + srow * AT_P + sch) = vreg;
        CH_BAR();
    }
    const float ltot = lsum + xor32(lsum, lane), inv = 1.f / ltot;
    bf16* yo = F.Y + (size_t)(row0 + q0 + r) * D + 768 + h * 64;
#pragma unroll
    for (int g4 = 0; g4 < 4; ++g4) {
        const int d = 8 * g4 + 4 * hh;
        st_bf4(yo + d, (f32x4){O0[4 * g4] * inv, O0[4 * g4 + 1] * inv, O0[4 * g4 + 2] * inv, O0[4 * g4 + 3] * inv});
        st_bf4(yo + 32 + d, (f32x4){O1[4 * g4] * inv, O1[4 * g4 + 1] * inv, O1[4 * g4 + 2] * inv, O1[4 * g4 + 3] * inv});
    }
}

constexpr int TP = 72;
constexpr int TSZ = 64 * TP;
enum { SL_A = 0, SL_AT, SL_B, SL_K, SL_R, SL_BT, SL_KT, SL_VT, SL_AAK, SL_ARB, SL_ARK, SL_P, SL_PT, SL_T, SL_S, N_SLOT };
constexpr int CH_F32_OFF = N_SLOT * TSZ * 2;
static_assert(CH_F32_OFF + 1024 + 9 * 256 <= 143360, "chunk LDS map");

template <bool TRANS>
__device__ __forceinline__ void mm_nt(f32x4 (&acc)[2], const LAS bf16* X, const LAS bf16* Y, int R0, int C0, int fr, int fq) {
    bf16x8 xf[2], yf[2][2];
#pragma unroll
    for (int ks = 0; ks < 2; ++ks) xf[ks] = *(const LAS bf16x8*)(X + (R0 + fr) * TP + 32 * ks + 8 * fq);
#pragma unroll
    for (int n = 0; n < 2; ++n)
#pragma unroll
        for (int ks = 0; ks < 2; ++ks) yf[n][ks] = *(const LAS bf16x8*)(Y + (C0 + 16 * n + fr) * TP + 32 * ks + 8 * fq);
#pragma unroll
    for (int n = 0; n < 2; ++n)
#pragma unroll
        for (int ks = 0; ks < 2; ++ks)
            acc[n] = TRANS ? __builtin_amdgcn_mfma_f32_16x16x32_bf16(xf[ks], yf[n][ks], acc[n], 0, 0, 0) : __builtin_amdgcn_mfma_f32_16x16x32_bf16(yf[n][ks], xf[ks], acc[n], 0, 0, 0);
}
__device__ __forceinline__ bf16x8 cat4(s16x4 a, s16x4 b) { return __builtin_shufflevector(a, b, 0, 1, 2, 3, 4, 5, 6, 7); }
__device__ __forceinline__ unsigned tr_addr(const LAS bf16* src, int rb, int fr, int fq) { return (unsigned)(uintptr_t)src + (unsigned)(((8 * fq + (fr >> 2)) * TP + rb + 4 * (fr & 3)) * 2); }
__device__ __forceinline__ void ldtr2(bf16x8 (&f)[2], unsigned a) {
    s16x4 o0, o1, o2, o3;
    asm volatile("ds_read_b64_tr_b16 %0, %4\n\tds_read_b64_tr_b16 %1, %4 offset:576\n\tds_read_b64_tr_b16 %2, %4 offset:4608\n\tds_read_b64_tr_b16 %3, %4 offset:5184\n\ts_waitcnt lgkmcnt(0)"
                 : "=&v"(o0), "=&v"(o1), "=&v"(o2), "=&v"(o3) : "v"(a) : "memory");
    f[0] = cat4(o0, o1); f[1] = cat4(o2, o3);
}
__device__ __forceinline__ void ldtr4(bf16x8 (&f)[2][2], unsigned a) {
    s16x4 o0, o1, o2, o3, o4, o5, o6, o7;
    asm volatile("ds_read_b64_tr_b16 %0, %8\n\tds_read_b64_tr_b16 %1, %8 offset:576\n\tds_read_b64_tr_b16 %2, %8 offset:4608\n\tds_read_b64_tr_b16 %3, %8 offset:5184\n\t"
                 "ds_read_b64_tr_b16 %4, %8 offset:32\n\tds_read_b64_tr_b16 %5, %8 offset:608\n\tds_read_b64_tr_b16 %6, %8 offset:4640\n\tds_read_b64_tr_b16 %7, %8 offset:5216\n\ts_waitcnt lgkmcnt(0)"
                 : "=&v"(o0), "=&v"(o1), "=&v"(o2), "=&v"(o3), "=&v"(o4), "=&v"(o5), "=&v"(o6), "=&v"(o7) : "v"(a) : "memory");
    f[0][0] = cat4(o0, o1); f[0][1] = cat4(o2, o3); f[1][0] = cat4(o4, o5); f[1][1] = cat4(o6, o7);
}
template <bool XT, bool YT>
__device__ __forceinline__ void mm_g(f32x4 (&acc)[2], const LAS bf16* X, const LAS bf16* Y, int R0, int C0, int fr, int fq) {
    bf16x8 xf[2], yf[2][2];
    if (!XT) {
#pragma unroll
        for (int ks = 0; ks < 2; ++ks) xf[ks] = *(const LAS bf16x8*)(X + (R0 + fr) * TP + 32 * ks + 8 * fq);
    }
    if (!YT) {
#pragma unroll
        for (int n = 0; n < 2; ++n)
#pragma unroll
            for (int ks = 0; ks < 2; ++ks) yf[n][ks] = *(const LAS bf16x8*)(Y + (C0 + 16 * n + fr) * TP + 32 * ks + 8 * fq);
    }
    if (XT) ldtr2(xf, tr_addr(X, R0, fr, fq));
    if (YT) ldtr4(yf, tr_addr(Y, C0, fr, fq));
#pragma unroll
    for (int n = 0; n < 2; ++n)
#pragma unroll
        for (int ks = 0; ks < 2; ++ks) acc[n] = __builtin_amdgcn_mfma_f32_16x16x32_bf16(yf[n][ks], xf[ks], acc[n], 0, 0, 0);
}
__device__ __forceinline__ void st_tile4(LAS bf16* p, f32x4 v) { u32x2 w; w.x = cvtpk(v.x, v.y); w.y = cvtpk(v.z, v.w); *(LAS u32x2*)p = w; }
__device__ __forceinline__ void zero2(f32x4 (&a)[2]) { a[0] = (f32x4){0.f, 0.f, 0.f, 0.f}; a[1] = a[0]; }
__device__ __forceinline__ f32x4 unbf4(u32x2 w) { f32x4 r; r.x = __uint_as_float(w.x << 16); r.y = __uint_as_float(w.x & 0xffff0000u); r.z = __uint_as_float(w.y << 16); r.w = __uint_as_float(w.y & 0xffff0000u); return r; }
__device__ __forceinline__ void tile_transpose(LAS bf16* dst, const LAS bf16* src, const bf16x8 (&idf)[2][2], int R0, int C0, int fr, int fq) {
    bf16x8 xf[2];
#pragma unroll
    for (int ks = 0; ks < 2; ++ks) xf[ks] = *(const LAS bf16x8*)(src + (R0 + fr) * TP + 32 * ks + 8 * fq);
#pragma unroll
    for (int n = 0; n < 2; ++n) {
        f32x4 acc = (f32x4){0.f, 0.f, 0.f, 0.f};
#pragma unroll
        for (int ks = 0; ks < 2; ++ks) acc = __builtin_amdgcn_mfma_f32_16x16x32_bf16(xf[ks], idf[n][ks], acc, 0, 0, 0);
        st_tile4(dst + (C0 + 16 * n + fr) * TP + R0 + 4 * fq, acc);
    }
}
__device__ __forceinline__ void make_identity_frags(bf16x8 (&idf)[2][2], int C0, int fr, int fq) {
#pragma unroll
    for (int n = 0; n < 2; ++n)
#pragma unroll
        for (int ks = 0; ks < 2; ++ks) {
            const int d = (C0 + 16 * n + fr) - (32 * ks + 8 * fq);
            u32x4 iw = (u32x4){0u, 0u, 0u, 0u};
            const unsigned one = (d & 1) ? 0x3f800000u : 0x00003f80u;
            if (d >= 0 && d < 8) { if ((d >> 1) == 0) iw.x = one; else if ((d >> 1) == 1) iw.y = one; else if ((d >> 1) == 2) iw.z = one; else iw.w = one; }
            idf[n][ks] = __builtin_bit_cast(bf16x8, iw);
        }
}
__device__ __forceinline__ void st_bf4_fast(bf16* p, f32x4 v) { u32x2 w; w.x = cvtpk(v.x, v.y); w.y = cvtpk(v.z, v.w); *(u32x2*)p = w; }

template <int MIX> struct RawRow;
template <> struct RawRow<0> { u32x2 r[3], k[3], v[3], E, a; };
template <> struct RawRow<1> { u32x2 x[3][3]; float bd, ad; };
template <> struct RawRow<2> { u32x2 q, k, v, ad[4]; };
__device__ __forceinline__ u32x2 ldraw(const bf16* p, bool ok) { return ok ? *(const u32x2*)p : (u32x2){0u, 0u}; }
__device__ __forceinline__ void load_raw(RawRow<0>& w, Frame& F, int dir, int h, int row, bool hasp, bool hasn, int sq) {
    const int c = h * 64 + 4 * sq; const bf16* p = F.P + (size_t)row * NP + PA + c;
    w.r[0] = ldraw(p - NP, hasp); w.r[1] = ldraw(p, true); w.r[2] = ldraw(p + NP, hasn);
    w.k[0] = ldraw(p + 256 - NP, hasp); w.k[1] = ldraw(p + 256, true); w.k[2] = ldraw(p + 256 + NP, hasn);
    w.v[0] = ldraw(p + 512 - NP, hasp); w.v[1] = ldraw(p + 512, true); w.v[2] = ldraw(p + 512 + NP, hasn);
    w.E = *(const u32x2*)(F.FEAT + (size_t)row * NFEAT + dir * 256 + c); w.a = *(const u32x2*)(F.FEAT + (size_t)row * NFEAT + 512 + dir * 256 + c);
}
__device__ __forceinline__ void load_raw(RawRow<1>& w, Frame& F, int dir, int h, int row, bool hasp, bool hasn, int sq) {
    const int c = h * 64 + 4 * sq; const bf16* p = F.P + (size_t)row * NP + PC + c;
#pragma unroll
    for (int part = 0; part < 3; ++part) { w.x[part][0] = ldraw(p + 256 * part - NP, hasp); w.x[part][1] = ldraw(p + 256 * part, true); w.x[part][2] = ldraw(p + 256 * part + NP, hasn); }
    w.bd = bf2f(F.P[(size_t)row * NP + PC + 1024 + dir * 4 + h]); w.ad = bf2f(F.P[(size_t)row * NP + PC + 1032 + dir * 4 + h]);
}
__device__ __forceinline__ void load_raw(RawRow<2>& w, Frame& F, int dir, int h, int row, bool hasp, bool hasn, int sq) {
    const bf16* p = F.P + (size_t)row * NP + PB;
    const int kx = (sq < 8) ? 4 * sq : 0;
    w.q = *(const u32x2*)(p + h * 32 + kx); w.k = *(const u32x2*)(p + 128 + h * 32 + kx); w.v = *(const u32x2*)(p + 256 + h * 64 + 4 * sq);
#pragma unroll
    for (int j = 0; j < 4; ++j) w.ad[j] = *(const u32x2*)(p + 512 + dir * 16 + 4 * j);
}

template <int MIX  >
__device__ __forceinline__ void chunk_item(Frame& F, int l, int s, int dir, int h) {
    LAS bf16* tl = (LAS bf16*)F.lds;
#define SLOT(x) (tl + (x) * TSZ)
    LAS float* fa = (LAS float*)(F.lds + CH_F32_OFF);
    LAS float* LGE = (LAS float*)(F.lds + SL_AAK * TSZ * 2);
    LAS float* TOT = LGE + 4096;
    LAS float* AD = (LAS float*)(F.lds + SL_T * TSZ * 2);
    LAS float* AS = AD + 1024; LAS float* MS = AD + 1536;
    LAS float* TD = (LAS float*)(F.lds + SL_K * TSZ * 2);
    LAS bf16* M2T = (LAS bf16*)(TD + 1024);
    const int T = s < 16 ? 256 : 1024, row0 = seq_row0(s), nch = T / 64, tid = F.tid, lane = F.lane, wv = F.wave;
    const int fr = lane & 15, fq = lane >> 4, R0 = 16 * (wv >> 1), C0 = 32 * (wv & 1);
    const int stok = tid >> 4, sq = tid & 15;
    f32x4 sacc[2]; zero2(sacc);
    if (s >= 16) {
        const int b = s - 16;
#pragma unroll
        for (int n = 0; n < 2; ++n) {
            const int v = R0 + fr, k = C0 + 16 * n + 4 * fq;
            if (MIX == 0) sacc[n] = *(const f32x4*)(F.in[I_SR] + ((((size_t)(b * 2 + l) * 2 + dir) * 4 + h) * 64 + v) * 64 + k);
            else if (MIX == 1) { const float* sp = F.in[I_SD] + (((size_t)(b * 2 + l) * 2 + dir) * 4 + h) * 64 * 64 + v;
#pragma unroll
                for (int e = 0; e < 4; ++e) sacc[n][e] = sp[(size_t)(k + e) * 64]; }
            else if (k < 32) { const float* sp = F.in[I_SG] + (((size_t)(b * 2 + l) * 2 + dir) * 4 + h) * 32 * 64 + v;
#pragma unroll
                for (int e = 0; e < 4; ++e) sacc[n][e] = sp[(size_t)(k + e) * 64]; }
        }
    }
    LAS float* PRM = fa + 256;
    if (MIX == 0 && tid < 320) { const int q = tid >> 6, k = tid & 63, c = h * 64 + k;
        PRM[q * 64 + k] = (q < 3) ? F.in[I_MU][l * 1184 + PA + 256 * q + c] : ((q == 3) ? F.in[I_KK][l * 256 + c] : F.in[I_KA][l * 256 + c]); }
    if (MIX == 1) { for (int idx = tid; idx < 576; idx += 512) { const int q = idx >> 6, k = idx & 63, part = q / 3, tap = q % 3; PRM[q * 64 + k] = F.in[I_DCV][l * 3 * 768 + tap * 768 + part * 256 + h * 64 + k]; } }
    float dl_a = 0.f, dl_dt = 0.f;
    if (MIX == 1) { dl_a = -__expf(F.in[I_DAL][(l * 2 + dir) * 4 + h]); dl_dt = F.in[I_DDT][(l * 2 + dir) * 4 + h]; }
    RawRow<MIX> raw[2];
#pragma unroll
    for (int rr = 0; rr < 2; ++rr) { const int i = stok + 32 * rr, tb0 = dir == 0 ? 0 : T - 64, t = tb0 + (dir == 0 ? i : 63 - i); load_raw(raw[rr], F, dir, h, row0 + t, t > 0, t < T - 1, sq); }
    CH_BAR();
#pragma unroll 1
    for (int ci = 0; ci < nch; ++ci) {
        const int tb = dir == 0 ? 64 * ci : T - 64 * (ci + 1);
        int lane_ = F.lane; asm volatile("" : "+v"(lane_));
        const int tid = F.wave * 64 + lane_, lane = lane_, fr = lane_ & 15, fq = lane_ >> 4, stok = tid >> 4, sq = tid & 15;
        f32x4 pA[2], pB[2], pK[2], pR[2], pE[2];
        f32x4 prm[9];
        if (MIX == 0) {
#pragma unroll
            for (int q = 0; q < 5; ++q) prm[q] = *(const LAS f32x4*)(PRM + q * 64 + 4 * sq); }
        if (MIX == 1) {
#pragma unroll
            for (int q = 0; q < 9; ++q) prm[q] = *(const LAS f32x4*)(PRM + q * 64 + 4 * sq); }
        float bt[2] = {0.f, 0.f};
#pragma unroll
        for (int rr = 0; rr < 2; ++rr) {
            const int i = stok + 32 * rr;
            if constexpr (MIX == 0) {
                const RawRow<0>& w = raw[rr];
                const f32x4 rc = unbf4(w.r[1]), kc = unbf4(w.k[1]), vc = unbf4(w.v[1]);
                const f32x4 r4 = rc + prm[0] * ((unbf4(w.r[0]) + unbf4(w.r[2])) * 0.5f - rc), k4 = kc + prm[1] * ((unbf4(w.k[0]) + unbf4(w.k[2])) * 0.5f - kc), v4 = vc + prm[2] * ((unbf4(w.v[0]) + unbf4(w.v[2])) * 0.5f - vc);
                const f32x4 E4 = unbf4(w.E), a4 = unbf4(w.a);
                f32x4 kk4 = k4 * prm[3];
                kk4 = kk4 * rsqrtf(row16_sum(sum4q(kk4)) + 1e-6f);
                pA[rr] = kk4; pB[rr] = kk4 * a4; pK[rr] = k4 * ((a4 - 1.f) * prm[4] + 1.f); pR[rr] = r4; pE[rr] = E4;
                *(LAS f32x4*)(LGE + i * 64 + 4 * sq) = E4; st_tile4(SLOT(SL_VT) + i * TP + 4 * sq, v4);
            } else if constexpr (MIX == 2) {
                const RawRow<2>& w = raw[rr];
                f32x4 q4 = (f32x4){0.f, 0.f, 0.f, 0.f}, k4 = q4, E4 = q4;
                if (sq < 8) {
                    const int kx = 4 * sq;
                    q4 = unbf4(w.q) * 0.17677669529f; k4 = unbf4(w.k);
                    const float* au = F.in[I_GAU] + (size_t)(l * 2 + dir) * 16 * 128 + h * 32 + kx;
                    f32x4 x4 = *(const f32x4*)(F.in[I_GAB] + (l * 2 + dir) * 128 + h * 32 + kx);
#pragma unroll
                    for (int jj = 0; jj < 4; ++jj) { const f32x4 ad = unbf4(w.ad[jj]);
#pragma unroll
                        for (int j = 0; j < 4; ++j) x4 += *(const f32x4*)(au + (4 * jj + j) * 128) * ad[j]; }
                    E4 = (f32x4){softplusf(-x4.x), softplusf(-x4.y), softplusf(-x4.z), softplusf(-x4.w)} * (1.f / 16.f);
                }
                pK[rr] = k4; pR[rr] = q4; pE[rr] = E4;
                *(LAS f32x4*)(LGE + i * 64 + 4 * sq) = E4;
                st_tile4(SLOT(SL_VT) + i * TP + 4 * sq, unbf4(w.v));
            } else {
                const RawRow<1>& w = raw[rr];
                f32x4 o3[3];
#pragma unroll
                for (int part = 0; part < 3; ++part) {
                    const f32x4 y = unbf4(w.x[part][0]) * prm[part * 3 + 0] + unbf4(w.x[part][1]) * prm[part * 3 + 1] + unbf4(w.x[part][2]) * prm[part * 3 + 2];
                    o3[part] = (f32x4){siluf(y.x), siluf(y.y), siluf(y.z), siluf(y.w)};
                }
                pA[rr] = o3[0] * (rsqrtf(row16_sum(sum4q(o3[0])) + 1e-6f) * 0.125f);
                pK[rr] = o3[1] * rsqrtf(row16_sum(sum4q(o3[1])) + 1e-6f);
                pR[rr] = o3[2];
                bt[rr] = sigm(w.bd);
                if (sq == 0) { fa[192 + i] = dl_a * softplusf(w.ad + dl_dt); fa[128 + i] = bt[rr]; }
            }
        }
        CH_BAR();
        if (MIX != 1) {
            const int k = tid & 63, tg = tid >> 6; float ev[8];
#pragma unroll
            for (int j = 0; j < 8; ++j) ev[j] = LGE[(8 * tg + j) * 64 + k];
            float p = 0.f;
#pragma unroll
            for (int j = 0; j < 8; ++j) { p += ev[j]; LGE[(8 * tg + j) * 64 + k] = p; }
            TOT[tg * 64 + k] = p;
        } else if (tid < 64) {
            float acc = fa[192 + tid];
            acc += DPPF(acc, 0x111); acc += DPPF(acc, 0x112); acc += DPPF(acc, 0x114); acc += DPPF(acc, 0x118);
            const float t0 = __int_as_float(__builtin_amdgcn_readlane(__float_as_int(acc), 15)), t1 = __int_as_float(__builtin_amdgcn_readlane(__float_as_int(acc), 31)), t2 = __int_as_float(__builtin_amdgcn_readlane(__float_as_int(acc), 47));
            acc += (tid >= 48) ? (t0 + t1) + t2 : (tid >= 32) ? t0 + t1 : (tid >= 16) ? t0 : 0.f;
            fa[64 + tid] = acc;
        }
#pragma unroll
        for (int n = 0; n < 2; ++n) st_tile4(SLOT(SL_S) + (R0 + fr) * TP + C0 + 16 * n + 4 * fq, sacc[n]);
        CH_BAR();
        float gC_delta = 0.f;
        if (MIX != 1) {
            f32x4 tot4 = (f32x4){0.f, 0.f, 0.f, 0.f}, pre[2];
#pragma unroll
            for (int g = 0; g < 8; ++g) { const f32x4 tg4 = *(const LAS f32x4*)(TOT + g * 64 + 4 * sq); if (g == (stok >> 3)) pre[0] = tot4; if (g == 4 + (stok >> 3)) pre[1] = tot4; tot4 += tg4; }
            if (stok == 0) *(LAS f32x4*)(fa + 4 * sq) = (f32x4){__expf(-tot4.x), __expf(-tot4.y), __expf(-tot4.z), __expf(-tot4.w)};
#pragma unroll
            for (int rr = 0; rr < 2; ++rr) {
                const int i = stok + 32 * rr;
                const f32x4 lg = *(const LAS f32x4*)(LGE + i * 64 + 4 * sq) + pre[rr];
                f32x4 einv, eg, ec, ep;
#pragma unroll
                for (int e = 0; e < 4; ++e) { einv[e] = __expf(lg[e]); eg[e] = __expf(-lg[e]); ep[e] = __expf(pE[rr][e] - lg[e]); }
                (void)ec;
                const f32x4 Rt = pR[rr] * eg, Kh = pK[rr] * einv;
                st_tile4(SLOT(SL_R) + i * TP + 4 * sq, Rt);
                st_tile4(SLOT(SL_KT) + i * TP + 4 * sq, Kh);
                if (MIX == 0) {
                    const f32x4 At = pA[rr] * ep * -1.f, Bh = pB[rr] * einv;
                    st_tile4(SLOT(SL_AT) + i * TP + 4 * sq, At); st_tile4(SLOT(SL_BT) + i * TP + 4 * sq, Bh);
                }
            }
        } else {
            const float gcC = fa[64 + 63]; gC_delta = __expf(gcC);
#pragma unroll
            for (int rr = 0; rr < 2; ++rr) {
                const int i = stok + 32 * rr; const float gci = fa[64 + i], eg = __expf(gci), ec = __expf(gcC - gci);
                st_tile4(SLOT(SL_A) + i * TP + 4 * sq, pA[rr]);
                st_tile4(SLOT(SL_K) + i * TP + 4 * sq, pK[rr]);
                st_tile4(SLOT(SL_R) + i * TP + 4 * sq, pA[rr] * eg);
                const f32x4 At = pK[rr] * (-bt[rr] * eg), Bb = pK[rr] * ec, bv = pR[rr] * bt[rr];
                st_tile4(SLOT(SL_AT) + i * TP + 4 * sq, At); st_tile4(SLOT(SL_BT) + i * TP + 4 * sq, Bb); st_tile4(SLOT(SL_VT) + i * TP + 4 * sq, bv);
            }
        }
        if (ci + 1 < nch) {
            const int tbn = dir == 0 ? 64 * (ci + 1) : T - 64 * (ci + 2);
#pragma unroll
            for (int rr = 0; rr < 2; ++rr) { const int i = stok + 32 * rr, t = tbn + (dir == 0 ? i : 63 - i); load_raw(raw[rr], F, dir, h, row0 + t, t > 0, t < T - 1, sq); }
        }
        CH_BAR();
        if (MIX != 2) {
            { LAS u32x2* zp = (LAS u32x2*)(SLOT(SL_PT) + (tid >> 3) * TP + (tid & 7) * 8); zp[0] = (u32x2){0u, 0u}; zp[1] = (u32x2){0u, 0u}; }
            f32x4 a1[2], a3[2]; zero2(a1); zero2(a3);
            if (MIX == 0) { mm_nt<false>(a1, SLOT(SL_AT), SLOT(SL_BT), R0, C0, fr, fq); mm_nt<false>(a3, SLOT(SL_R), SLOT(SL_BT), R0, C0, fr, fq); }
            else { mm_nt<false>(a1, SLOT(SL_K), SLOT(SL_K), R0, C0, fr, fq); mm_nt<false>(a3, SLOT(SL_A), SLOT(SL_K), R0, C0, fr, fq); }
#pragma unroll
            for (int n = 0; n < 2; ++n) {
                const int r = R0 + fr, c0 = C0 + 16 * n + 4 * fq;
                f32x4 av, rb;
#pragma unroll
                for (int e = 0; e < 4; ++e) {
                    const int c = c0 + e; float x = a1[n][e], y = a3[n][e];
                    if (MIX == 1) { const float dc = __expf(fa[64 + r] - fa[64 + c]); x = -fa[128 + r] * dc * x; y = dc * y; }
                    av[e] = (c < r) ? x : 0.f; rb[e] = (c <= r) ? y : 0.f;
                }
                st_tile4(SLOT(SL_P) + r * TP + c0, av); st_tile4(SLOT(SL_ARB) + r * TP + c0, rb);
                const int br = wv >> 1, bc = 2 * (wv & 1) + n;
                if (br == bc) *(LAS f32x4*)(AD + br * 256 + fr * 16 + 4 * fq) = av;
                if (br == bc + 1 && (bc & 1) == 0) *(LAS f32x4*)(AS + (bc >> 1) * 256 + fr * 16 + 4 * fq) = av;
            }
        }
        if (MIX != 1) {
            f32x4 a4[2]; zero2(a4); mm_nt<false>(a4, SLOT(SL_R), SLOT(SL_KT), R0, C0, fr, fq);
            f32x4 a2[2]; zero2(a2); if (MIX == 0) mm_nt<false>(a2, SLOT(SL_AT), SLOT(SL_KT), R0, C0, fr, fq);
#pragma unroll
            for (int n = 0; n < 2; ++n) {
                const int r = R0 + fr, c0 = C0 + 16 * n + 4 * fq; f32x4 rk, ak;
#pragma unroll
                for (int e = 0; e < 4; ++e) { rk[e] = (c0 + e <= r) ? a4[n][e] : 0.f; ak[e] = (c0 + e < r) ? a2[n][e] : 0.f; }
                st_tile4(SLOT(SL_ARK) + r * TP + c0, rk);
                if (MIX == 0) st_tile4(SLOT(SL_AAK) + r * TP + c0, ak);
            }
        }
        CH_BAR();
        f32x4 zacc[2]; zero2(zacc);
        if (MIX != 2) {
            {   f32x4 G[2];
                if (MIX == 0) { zero2(G); mm_g<true, false>(G, SLOT(SL_VT), SLOT(SL_AAK), R0, C0, fr, fq); }
                else {
#pragma unroll
                    for (int n = 0; n < 2; ++n)
#pragma unroll
                        for (int e = 0; e < 4; ++e) G[n][e] = bf2f(SLOT(SL_VT)[(C0 + 16 * n + 4 * fq + e) * TP + R0 + fr]);
                }
                mm_nt<false>(G, SLOT(SL_S), SLOT(SL_AT), R0, C0, fr, fq);
#pragma unroll
                for (int n = 0; n < 2; ++n) st_tile4(SLOT(SL_A) + (R0 + fr) * TP + C0 + 16 * n + 4 * fq, G[n]); }
            if (wv == 0) {
                int b = lane >> 4, c = lane & 15; asm volatile("" : "+v"(b), "+v"(c)); float tcol[16];
                tcol[0] = (c == 0) ? 1.f : 0.f;
                f32x4 cur[4], nxt[4];
#pragma unroll
                for (int j4 = 0; j4 < 4; ++j4) { cur[j4] = (f32x4){0.f, 0.f, 0.f, 0.f}; nxt[j4] = cur[j4]; }
                cur[0] = *(const LAS f32x4*)(AD + b * 256 + 16);
#pragma unroll
                for (int r = 1; r < 16; ++r) {
                    if (r + 1 < 16) {
#pragma unroll
                        for (int j4 = 0; j4 < (r + 4) / 4; ++j4) nxt[j4] = *(const LAS f32x4*)(AD + b * 256 + (r + 1) * 16 + 4 * j4);
                    }
                    float acc = (r == c) ? 1.f : 0.f;
#pragma unroll
                    for (int j = 0; j < r; ++j) acc += cur[j >> 2][j & 3] * tcol[j];
                    tcol[r] = acc;
#pragma unroll
                    for (int j4 = 0; j4 < 4; ++j4) cur[j4] = nxt[j4];
                    __builtin_amdgcn_sched_barrier(0);
                }
#pragma unroll
                for (int r = 0; r < 16; ++r) { TD[b * 256 + r * 16 + c] = tcol[r]; SLOT(SL_PT)[(16 * b + r) * TP + 16 * b + c] = (bf16)f2bf(tcol[r]); }
                u32x4 w0, w1;
                w0.x = cvtpk(tcol[0], tcol[1]); w0.y = cvtpk(tcol[2], tcol[3]); w0.z = cvtpk(tcol[4], tcol[5]); w0.w = cvtpk(tcol[6], tcol[7]);
                w1.x = cvtpk(tcol[8], tcol[9]); w1.y = cvtpk(tcol[10], tcol[11]); w1.z = cvtpk(tcol[12], tcol[13]); w1.w = cvtpk(tcol[14], tcol[15]);
                *(LAS u32x4*)(SLOT(SL_B) + (16 * b + c) * TP + 16 * b) = w0; *(LAS u32x4*)(SLOT(SL_B) + (16 * b + c) * TP + 16 * b + 8) = w1;
            } else if (wv == 1) {
                LAS u32x2* zp = (LAS u32x2*)(SLOT(SL_B) + (16 + (lane >> 2)) * TP + (lane & 3) * 4); zp[0] = (u32x2){0u, 0u};
            }
            CH_BAR();
            {
                const int which = tid >> 8, r = (tid >> 4) & 15, c = tid & 15, bA = 2 * which + 1, bT = 2 * which;
                float m = 0.f;
#pragma unroll
                for (int j = 0; j < 16; ++j) m += AS[which * 256 + r * 16 + j] * TD[bT * 256 + j * 16 + c];
                MS[which * 256 + r * 16 + c] = m;
                CH_BAR();
                float v = 0.f;
#pragma unroll
                for (int j = 0; j < 16; ++j) v += TD[bA * 256 + r * 16 + j] * MS[which * 256 + j * 16 + c];
                SLOT(SL_PT)[(16 * bA + r) * TP + 16 * bT + c] = (bf16)f2bf(v);
                SLOT(SL_B)[(16 * bT + c) * TP + 16 * bA + r] = (bf16)f2bf(v);
            }
            CH_BAR();
            if (wv < 4) {
                const int a = wv >> 1, bq = wv & 1;
                const bf16x8 xf = *(const LAS bf16x8*)(SLOT(SL_P) + (32 + 16 * a + fr) * TP + 8 * fq), yf = *(const LAS bf16x8*)(SLOT(SL_B) + (16 * bq + fr) * TP + 8 * fq);
                f32x4 m2 = (f32x4){0.f, 0.f, 0.f, 0.f};
                m2 = __builtin_amdgcn_mfma_f32_16x16x32_bf16(xf, yf, m2, 0, 0, 0);
                st_tile4(M2T + (16 * bq + fr) * TP + 16 * a + 4 * fq, m2);
            }
            CH_BAR();
            if (wv < 4) {
                const int a = wv >> 1, bq = wv & 1;
                const bf16x8 xf = *(const LAS bf16x8*)(SLOT(SL_PT) + (32 + 16 * a + fr) * TP + 32 + 8 * fq), yf = *(const LAS bf16x8*)(M2T + (16 * bq + fr) * TP + 8 * fq);
                f32x4 tb4 = (f32x4){0.f, 0.f, 0.f, 0.f};
                tb4 = __builtin_amdgcn_mfma_f32_16x16x32_bf16(yf, xf, tb4, 0, 0, 0);
                st_tile4(SLOT(SL_PT) + (32 + 16 * a + fr) * TP + 16 * bq + 4 * fq, tb4);
            }
            CH_BAR();
            mm_nt<false>(zacc, SLOT(SL_A), SLOT(SL_PT), R0, C0, fr, fq);
#pragma unroll
            for (int n = 0; n < 2; ++n) st_tile4(SLOT(SL_P) + (R0 + fr) * TP + C0 + 16 * n + 4 * fq, zacc[n]);
            CH_BAR();
        }
        {
            f32x4 y[2]; zero2(y);
            mm_nt<false>(y, SLOT(SL_R), SLOT(SL_S), R0, C0, fr, fq);
            if (MIX != 2) mm_nt<false>(y, SLOT(SL_ARB), SLOT(SL_P), R0, C0, fr, fq);
            if (MIX != 1) mm_g<false, true>(y, SLOT(SL_ARK), SLOT(SL_VT), R0, C0, fr, fq);
            const int i = R0 + fr, t = tb + (dir == 0 ? i : 63 - i);
            bf16* yo = F.YP + ((size_t)(MIX * 2 + dir) * M + row0 + t) * 256 + h * 64 + C0 + 4 * fq;
            st_bf4_fast(yo, y[0]); st_bf4_fast(yo + 16, y[1]);
            if (MIX == 1) {
#pragma unroll
                for (int n = 0; n < 2; ++n) sacc[n] = sacc[n] * gC_delta;
                mm_g<false, true>(sacc, SLOT(SL_P), SLOT(SL_BT), R0, C0, fr, fq);
            } else {
                if (MIX == 0) mm_g<false, true>(sacc, SLOT(SL_P), SLOT(SL_BT), R0, C0, fr, fq);
                mm_g<true, true>(sacc, SLOT(SL_VT), SLOT(SL_KT), R0, C0, fr, fq);
#pragma unroll
                for (int n = 0; n < 2; ++n) sacc[n] = sacc[n] * *(const LAS f32x4*)(fa + C0 + 16 * n + 4 * fq);
            }
        }
        CH_BAR();
    }
    if (s < 16) {
#pragma unroll
        for (int n = 0; n < 2; ++n) {
            const int v = R0 + fr, k = C0 + 16 * n + 4 * fq;
            if (MIX == 0) *(f32x4*)(F.out + O_SR + ((((size_t)(s * 2 + l) * 2 + dir) * 4 + h) * 64 + v) * 64 + k) = sacc[n];
            else if (MIX == 1) { float* sp = F.out + O_SD + (((size_t)(s * 2 + l) * 2 + dir) * 4 + h) * 64 * 64 + v;
#pragma unroll
                for (int e = 0; e < 4; ++e) sp[(size_t)(k + e) * 64] = sacc[n][e]; }
            else if (k < 32) { float* sp = F.out + O_SG + (((size_t)(s * 2 + l) * 2 + dir) * 4 + h) * 32 * 64 + v;
#pragma unroll
                for (int e = 0; e < 4; ++e) sp[(size_t)(k + e) * 64] = sacc[n][e]; }
        }
    }
#undef SLOT
}

constexpr int Q_LAT = 192, Q_CTX = 384, Q_ATL = 128, Q_ATC = 64, Q_MIX = Q_LAT + Q_CTX + Q_ATL + Q_ATC;
constexpr int Q_CONV = (16 * 176 + 44 * 32) / 8, Q_TOTAL = Q_MIX + Q_CONV;
#define MKFRAME() Frame F; { kptr_t kp = (kptr_t)__builtin_amdgcn_kernarg_segment_ptr(); asm volatile("" : "+s"(kp)); \
    F.lds = (LAS unsigned char*)lds_raw; F.in = (inptr_t)kp; F.out = *(float* const __attribute__((address_space(4)))*)(kp + 8 * N_INPUTS); F.ws = *(unsigned char* const __attribute__((address_space(4)))*)(kp + 8 * N_INPUTS + 8); \
    { int l_; asm volatile("v_mbcnt_lo_u32_b32 %0, -1, 0\n\tv_mbcnt_hi_u32_b32 %0, -1, %0" : "=v"(l_)); int w_ = wave0, g_ = gridDim.x, b_ = blockIdx.x; asm volatile("" : "+s"(w_), "+s"(g_), "+s"(b_)); F.G = g_; F.bid = b_; F.lane = l_; F.wave = w_; F.tid = w_ * 64 + l_; } \
    F.X = F.out + O_Y; F.MOD = (float*)(F.ws + WS_MOD); \
    F.W1 = (bf16*)(F.ws + WS_W1); F.W2 = (bf16*)(F.ws + WS_W2); F.WIN = (bf16*)(F.ws + WS_WIN); F.WB = (bf16*)(F.ws + WS_WB); F.WO = (bf16*)(F.ws + WS_WO); \
    F.XN = (bf16*)(F.ws + WS_XN); F.Y = (bf16*)(F.ws + WS_Y); F.P = (bf16*)(F.ws + WS_P); F.H = (bf16*)(F.ws + WS_FEAT); \
    F.FEAT = (bf16*)(F.ws + WS_FEAT); F.YP = (bf16*)(F.ws + WS_YP); F.QN = (bf16*)(F.ws + WS_QN); F.KN = (bf16*)(F.ws + WS_KN); F.VT = (bf16*)(F.ws + WS_VT); \
    F.MG = (float*)(F.ws + WS_MG); F.ctl = (unsigned*)(F.ws + WS_CTL); }
__device__ __forceinline__ void scan_phase(Frame& F0, int l, int qi) {
    LAS unsigned char* lds_raw = F0.lds; const int wave0 = F0.wave;
    volatile LAS unsigned* misc = (volatile LAS unsigned*)(lds_raw + MISC_OFF);
    for (;;) {
        __syncthreads();
        MKFRAME();
        if (F.tid == 0) misc[0] = __hip_atomic_fetch_add(F.ctl + CW_Q + 64 * qi, 1u, __ATOMIC_RELAXED, __HIP_MEMORY_SCOPE_AGENT);
        __syncthreads();
        unsigned mo_ = MISC_OFF; asm volatile("" : "+v"(mo_));
        const int item = (int)*(volatile LAS unsigned*)(lds_raw + mo_);
        if (item >= Q_MIX) break;
        if (item < Q_LAT + Q_CTX) {
            int mix, s, rem;
            if (item < Q_LAT) { mix = item >> 6; rem = item & 63; s = 16 + (rem >> 3); }
            else { const int i2 = item - Q_LAT; mix = i2 >> 7; rem = i2 & 127; s = rem >> 3; }
            const int dir = (rem >> 2) & 1, h = rem & 3;
#ifndef CH_MASK
#define CH_MASK 7
#endif
            if (mix == 0) { if (CH_MASK & 1) chunk_item<0>(F, l, s, dir, h); else scan_item<0>(F, l, s, dir, h); }
            else if (mix == 1) { if (CH_MASK & 2) chunk_item<1>(F, l, s, dir, h); else scan_item<1>(F, l, s, dir, h); }
            else { if (CH_MASK & 4) chunk_item<2>(F, l, s, dir, h); else scan_item<2>(F, l, s, dir, h); }
        } else if (item < Q_LAT + Q_CTX + Q_ATL) {
            const int i2 = item - (Q_LAT + Q_CTX); attn_item(F, 16 + (i2 >> 4), (i2 >> 3) & 1, i2 & 7);
        } else if (item < Q_MIX) {
            const int i2 = item - (Q_LAT + Q_CTX + Q_ATL); attn_item(F, i2 >> 2, (i2 >> 1) & 1, i2 & 1);
        }
    }
}

__device__ __forceinline__ float sum4(f32x4 v) { return (v.x + v.y) + (v.z + v.w); }
__device__ __forceinline__ void post_phase(Frame& F, int l) {
    const int gw = F.bid * 8 + F.wave, NGW = F.G * 8, lane = F.lane;
    const float* mu = F.in[I_MU] + l * 1184;
    const int c = (lane >> 4) * 64 + (lane & 15) * 4, ch = (lane & 15) * 4;
    const f32x4 lng = *(const f32x4*)(F.in[I_LNG] + l * 256 + c), lnb = *(const f32x4*)(F.in[I_LNB] + l * 256 + c), kaw = *(const f32x4*)(F.in[I_KA] + l * 256 + c), rkw = *(const f32x4*)(F.in[I_RK] + l * 256 + c);
    const f32x4 gng = *(const f32x4*)(F.in[I_GNG] + l * 64 + ch), dng = *(const f32x4*)(F.in[I_DNG] + l * 64 + ch);
    const f32x4 mu_r = *(const f32x4*)(mu + PA + c), mu_k = *(const f32x4*)(mu + PA + 256 + c), mu_v = *(const f32x4*)(mu + PA + 512 + c);
    for (int rowb = 2 * gw; rowb < M; rowb += 2 * NGW) {
        u32x2 wy[2][6], wr[2][3], wk[2][3], wvv[2][3], wf[2][3], wg[2][2]; bool ok[2];
#pragma unroll
        for (int q = 0; q < 2; ++q) {
            const int row = rowb + q; ok[q] = row < M;
            if (ok[q]) {
                int s, t, T; row_geom(row, s, t, T); const bool hasp = t > 0, hasn = t < T - 1;
#pragma unroll
                for (int j = 0; j < 6; ++j) wy[q][j] = *(const u32x2*)(F.YP + ((size_t)j * M + row) * 256 + c);
                const bf16* p = F.P + (size_t)row * NP + PA + c; const u32x2 z = (u32x2){0u, 0u};
                wr[q][1] = *(const u32x2*)p; wk[q][1] = *(const u32x2*)(p + 256); wvv[q][1] = *(const u32x2*)(p + 512);
                if (q == 0) { wr[0][0] = hasp ? *(const u32x2*)(p - NP) : z; wk[0][0] = hasp ? *(const u32x2*)(p + 256 - NP) : z; wvv[0][0] = hasp ? *(const u32x2*)(p + 512 - NP) : z; }
                else { wr[1][2] = hasn ? *(const u32x2*)(p + NP) : z; wk[1][2] = hasn ? *(const u32x2*)(p + 256 + NP) : z; wvv[1][2] = hasn ? *(const u32x2*)(p + 512 + NP) : z; }
#pragma unroll
                for (int j = 0; j < 3; ++j) wf[q][j] = *(const u32x2*)(F.FEAT + (size_t)row * NFEAT + 512 + 256 * j + c);
                wg[q][0] = *(const u32x2*)(F.P + (size_t)row * NP + PB + 544 + c); wg[q][1] = *(const u32x2*)(F.P + (size_t)row * NP + PC + 768 + c);
            }
        }
        wr[0][2] = wr[1][1]; wk[0][2] = wk[1][1]; wvv[0][2] = wvv[1][1]; wr[1][0] = wr[0][1]; wk[1][0] = wk[0][1]; wvv[1][0] = wvv[0][1];
#pragma unroll
        for (int q = 0; q < 2; ++q) {
            if (!ok[q]) continue;
            const int row = rowb + q;
            {
                const f32x4 y = unbf4_(wy[q][0]) + unbf4_(wy[q][1]);
                const float mean = row16_sum(sum4(y)) * (1.f / 64.f); const f32x4 dv = y - mean;
                const float var = row16_sum(sum4(dv * dv)) * (1.f / 64.f);
                const f32x4 yn = dv * rsqrtf(var + 64e-5f) * lng + lnb;
                const f32x4 rc = unbf4_(wr[q][1]), kc = unbf4_(wk[q][1]), vc = unbf4_(wvv[q][1]);
                const f32x4 r4 = rc + mu_r * ((unbf4_(wr[q][0]) + unbf4_(wr[q][2])) * 0.5f - rc), k4 = kc + mu_k * ((unbf4_(wk[q][0]) + unbf4_(wk[q][2])) * 0.5f - kc), v4 = vc + mu_v * ((unbf4_(wvv[q][0]) + unbf4_(wvv[q][2])) * 0.5f - vc);
                const f32x4 af = unbf4_(wf[q][0]), ab = unbf4_(wf[q][1]), gg = unbf4_(wf[q][2]);
                const f32x4 kds = k4 * ((af + ab - 2.f) * kaw + 2.f);
                const float bs = row16_sum(sum4(r4 * kds * rkw));
                st_bf4(F.Y + (size_t)row * D + c, (yn + v4 * bs) * gg);
            }
            {
                const f32x4 o = unbf4_(wy[q][4]) + unbf4_(wy[q][5]);
                const float ms = row16_sum(sum4(o * o)) * (1.f / 64.f);
                const f32x4 rg = unbf4_(wg[q][0]);
                f32x4 sg; sg.x = siluf(rg.x); sg.y = siluf(rg.y); sg.z = siluf(rg.z); sg.w = siluf(rg.w);
                st_bf4(F.Y + (size_t)row * D + 256 + c, o * rsqrtf(ms + 1e-6f) * gng * sg);
            }
            {
                const f32x4 o = unbf4_(wy[q][2]) + unbf4_(wy[q][3]);
                const float ms = row16_sum(sum4(o * o)) * (1.f / 64.f);
                const f32x4 gt = unbf4_(wg[q][1]);
                f32x4 sg; sg.x = siluf(gt.x); sg.y = siluf(gt.y); sg.z = siluf(gt.z); sg.w = siluf(gt.w);
                st_bf4(F.Y + (size_t)row * D + 512 + c, o * rsqrtf(ms + 1e-6f) * dng * sg);
            }
        }
    }
}

#define GRID_BARRIER() do { unsigned char* ws_; { kptr_t kp = (kptr_t)__builtin_amdgcn_kernarg_segment_ptr(); asm volatile("" : "+s"(kp)); ws_ = *(unsigned char* const __attribute__((address_space(4)))*)(kp + 8 * N_INPUTS + 8); } \
    int l_; asm volatile("v_mbcnt_lo_u32_b32 %0, -1, 0\n\tv_mbcnt_hi_u32_b32 %0, -1, %0" : "=v"(l_)); \
    xcd_barrier((unsigned*)(ws_ + WS_CTL) + CW_BAR, (volatile LAS unsigned*)(lds_raw + MISC_OFF + 32), (wave0 == 0) && (l_ == 0)); } while (0)
#define PHASE(idx, ...) do { if (ph_lo <= (idx) && (idx) < ph_hi) { { const int probe_rep = 0; (void)probe_rep; __VA_ARGS__ } if ((idx) + 1 < ph_hi) GRID_BARRIER(); } } while (0)

__device__ __forceinline__ void ph_swiglu(Frame& F, int l, int sub) {
    pg8::Gemm g{F.XN, sub == 0 ? (bf16*)(F.ws + WS_P) : F.W1, M, 5632, 1024, 1024, 1024}; pg8::StaticOrder S; S.init(M, 5632, F.G, F.bid); pg8::EpiSwiglu E{F.H, F.ctl + CW_HDONE + (l * 2 + sub) * 48 * 64, F.ctl + (F.G == 256 ? CW_HLATE : CW_HDONE) + (l * 2 + sub) * 48 * 64};
    pg8::gemm_phase<pg8::EpiSwiglu>(F.lds, F.tid, g, S, E);
}
__device__ __forceinline__ void ph_res(Frame& F, int l, int res_kind, bool from_inputs) {
    pg8::Gemm g; pg8::EpiResNorm E; E.out = F.X; E.modl = F.MOD + (size_t)l * 9 * 9216;
    if (res_kind == 1) { g = pg8::Gemm{F.XN, F.WO, M, 1024, 1024, 1024, 1024}; E.gi = 5; E.coef = 1.f; }
    else { g = pg8::Gemm{F.H, res_kind == 0 ? (bf16*)(F.ws + WS_P + 11 * MiB) : F.W2, M, 1024, FF, FF, FF}; E.gi = (res_kind == 0) ? 2 : 8; E.coef = 0.5f; }
    if (from_inputs) { E.base0 = F.in[I_XP]; E.base1 = F.in[I_XS]; } else { E.base0 = F.X; E.base1 = F.X + (size_t)MC * D; }
    E.final_ = (res_kind == 2 && l == 1);
    const int nl = (res_kind == 2) ? l + 1 : l; E.ni = (res_kind == 2) ? 0 : res_kind + 1;
    E.ng = E.final_ ? F.in[I_FNG] : F.in[I_NG] + (nl * 3 + E.ni) * 1024;
    E.nmod = F.MOD + (size_t)(E.final_ ? 0 : nl) * 9 * 9216;
    E.xn = F.XN; E.xbuf = (float*)(F.ws + WS_XB); E.cnt = F.ctl + CW_SEAM + (l * 3 + res_kind) * 48 * 64; E.xnd = nullptr;
    if (res_kind == 1) { E.ready = nullptr; E.need = 0u; E.lready = nullptr; } else { E.ready = F.ctl + CW_HDONE + (l * 2 + (res_kind >> 1)) * 48 * 64; E.need = 22u * 8u;
        E.lready = (F.G == 256) ? F.ctl + CW_HLATE + (l * 2 + (res_kind >> 1)) * 48 * 64 : nullptr; }
    E.gridG = F.G;
    pg8::StaticOrder S; S.init(M, 1024, F.G, (res_kind != 1 && F.G == 256) ? ((F.bid + 192) & 255) : F.bid);
    pg8::gemm_phase<pg8::EpiResNorm>(F.lds, F.tid, g, S, E);
}
__device__ __forceinline__ void ph_p(Frame& F) {
    pg8::Gemm g{F.XN, F.WIN, M, NP, 1024, 1024, 1024}; pg8::StaticOrder S; S.init(M, NP, F.G, F.bid); pg8::EpiP E{F.P, NP};
    pg8::gemm_phase<pg8::EpiP>(F.lds, F.tid, g, S, E);
}
__device__ __forceinline__ void ph_p_conv(Frame& F, int l) {
    if (F.G == 256) { if (F.bid >= 160) conv_stride(F, l, 0, (F.bid - 160) * 8 + F.wave, 768); }
    else conv_stride(F, l, 0, F.bid * 8 + F.wave, F.G * 8);
}
__device__ __forceinline__ void ph_branch(Frame& F) {
    const int tid = F.tid, wid = F.wave, lane = F.lane, wr = wid >> 2, wc = wid & 3, fr = lane & 15, fq = lane >> 4;
    unsigned voffA[2], voffB[2];
#pragma unroll
    for (int i = 0; i < 2; ++i) { int R, C; pg8::stage_rc(tid * 16 + i * 8192, R, C); voffA[i] = (unsigned)(R * 1024 + C) * 2u;
        const int Rb = (R & ~31) + pg8::perm32(R & 31); voffB[i] = (unsigned)(Rb * 256 + C) * 2u; }
    const unsigned ldsw = (unsigned)wid * 1024u;
    const int aoff = pg8::lds_byte(wr * 64 + fr, fq * 8), boff = pg8::lds_byte(wc * 32 + fr, fq * 8);
    LAS unsigned char* lds = F.lds;
    constexpr int GOFF = 3 * 32768;
    const bool xo = (F.G == 256);
    const int k0 = xo ? (F.bid >> 3) : F.bid, kstep = xo ? 32 : F.G, kend = xo ? 96 : 768;
    const int nunits = (k0 < kend) ? (kend - k0 + kstep - 1) / kstep : 0, ntiles = nunits * 16;
    if (ntiles == 0) return;
#define BR_UNIT(ui_, pm_, pn_) const int kq_ = k0 + (ui_) * kstep; const int pm_ = xo ? 8 * (kq_ >> 3) + (F.bid & 7) : (kq_ >> 3), pn_ = kq_ & 7;
#define BR_STAGE(g_) do { BR_UNIT((g_) >> 4, spm_, spn_) const int kt_ = (g_) & 15, m_ = kt_ >> 2, kk_ = kt_ & 3; \
        const char* sa_ = (const char*)(F.Y + (size_t)spm_ * 128 * 1024) + (size_t)(256 * m_ + 64 * kk_) * 2; \
        const char* sb_ = (const char*)(F.WB + (size_t)spn_ * 128 * 256) + ((size_t)m_ * 1024 * 256 + 64 * kk_) * 2; \
        const int bo_ = ((g_) % 3) * 32768; \
        _Pragma("unroll") for (int i_ = 0; i_ < 2; ++i_) { \
            __builtin_amdgcn_global_load_lds((const unsigned*)(sa_ + voffA[i_]), (LAS unsigned*)(lds + bo_ + ldsw + i_ * 8192), 16, 0, 0); \
            __builtin_amdgcn_global_load_lds((const unsigned*)(sb_ + voffB[i_]), (LAS unsigned*)(lds + bo_ + 16384 + ldsw + i_ * 8192), 16, 0, 0); } } while (0)
    BR_STAGE(0); BR_STAGE(1);
    f32x4 mg[4][2], U[4][2];
    f32x4 Up[4][2]; u32x2 gwv[4][2];
#pragma unroll
    for (int mm = 0; mm < 4; ++mm)
#pragma unroll
        for (int n = 0; n < 2; ++n) { mg[mm][n] = (f32x4){0.f, 0.f, 0.f, 0.f}; U[mm][n] = (f32x4){0.f, 0.f, 0.f, 0.f}; Up[mm][n] = (f32x4){0.f, 0.f, 0.f, 0.f}; gwv[mm][n] = (u32x2){0u, 0u}; }
#define BR_GATE(mm_, n_, uu_, gw_) do { f32x4 gv_; gv_.x = __uint_as_float((gw_).x << 16); gv_.y = __uint_as_float((gw_).x & 0xffff0000u); gv_.z = __uint_as_float((gw_).y << 16); gv_.w = __uint_as_float((gw_).y & 0xffff0000u); \
        const f32x4 sg_ = (f32x4){sigm(gv_.x), sigm(gv_.y), sigm(gv_.z), sigm(gv_.w)}; mg[mm_][n_] += sg_ * (uu_); } while (0)
#pragma unroll 1
    for (int g = 0; g < ntiles; ++g) {
        BR_UNIT(g >> 4, pm, pn)
        const int kt = g & 15, row0 = pm * 128, n0 = pn * 128, cb = g % 3;
        if (kt >= 4) {
            const int sgi = kt & 3;
            if (sgi == 0) { BR_GATE(0, 0, Up[0][0], gwv[0][0]); BR_GATE(0, 1, Up[0][1], gwv[0][1]); }
            else if (sgi == 1) { BR_GATE(1, 0, Up[1][0], gwv[1][0]); BR_GATE(1, 1, Up[1][1], gwv[1][1]); }
            else if (sgi == 2) { BR_GATE(2, 0, Up[2][0], gwv[2][0]); BR_GATE(2, 1, Up[2][1], gwv[2][1]); }
            else { BR_GATE(3, 0, Up[3][0], gwv[3][0]); BR_GATE(3, 1, Up[3][1], gwv[3][1]); }
        }
        if (g + 1 >= ntiles) asm volatile("s_waitcnt vmcnt(0)" ::: "memory");
        else if ((g & 3) == 1 || (g & 3) == 2) asm volatile("s_waitcnt vmcnt(8)" ::: "memory");
        else asm volatile("s_waitcnt vmcnt(4)" ::: "memory");
        __builtin_amdgcn_s_barrier(); asm volatile("" ::: "memory");
        if (g + 2 < ntiles) BR_STAGE(g + 2);
        if ((kt & 3) == 0) {
            const bf16* gsrc = F.P + (size_t)row0 * NP + PG + 1024 * (kt >> 2) + n0;
#pragma unroll
            for (int p = 0; p < 4; ++p) { const int q = p * 512 + tid, grow = q >> 4, gch = q & 15;
                __builtin_amdgcn_global_load_lds((const unsigned*)(gsrc + (size_t)grow * NP + (gch ^ ((grow & 3) << 2)) * 8), (LAS unsigned*)(lds + GOFF + (p * 8 + wid) * 1040), 16, 0,   2); }
        }
        bf16x8 At[4][2], Bt[2][2];
#pragma unroll
        for (int mm = 0; mm < 4; ++mm)
#pragma unroll
            for (int k = 0; k < 2; ++k) At[mm][k] = *(const LAS bf16x8*)(lds + cb * 32768 + aoff + mm * 2048 + k * 1024);
#pragma unroll
        for (int n = 0; n < 2; ++n)
#pragma unroll
            for (int k = 0; k < 2; ++k) Bt[n][k] = *(const LAS bf16x8*)(lds + cb * 32768 + 16384 + boff + n * 2048 + k * 1024);
#pragma unroll
        for (int mm = 0; mm < 4; ++mm)
#pragma unroll
            for (int n = 0; n < 2; ++n)
#pragma unroll
                for (int k = 0; k < 2; ++k) U[mm][n] = __builtin_amdgcn_mfma_f32_16x16x32_bf16(Bt[n][k], At[mm][k], U[mm][n], 0, 0, 0);
        if ((kt & 3) == 3) {
#pragma unroll
            for (int mm = 0; mm < 4; ++mm) {
                const int rl = wr * 64 + mm * 16 + fr, cl = wc * 32 + 8 * fq;
                const u32x4 g4 = *(const LAS u32x4*)(lds + GOFF + (rl >> 2) * 1040 + (rl & 3) * 256 + (((cl >> 3) ^ ((rl & 3) << 2)) << 4));
#pragma unroll
                for (int n = 0; n < 2; ++n) {
                    const u32x2 gw = (n == 0) ? (u32x2){g4.x, g4.y} : (u32x2){g4.z, g4.w};
                    if (kt == 15) BR_GATE(mm, n, U[mm][n], gw);
                    else { Up[mm][n] = U[mm][n]; gwv[mm][n] = gw; }
                    U[mm][n] = (f32x4){0.f, 0.f, 0.f, 0.f};
                }
            }
        }
        if (kt == 15) {
#pragma unroll
            for (int mm = 0; mm < 4; ++mm) {
                const int row = row0 + wr * 64 + mm * 16 + fr, col = n0 + wc * 32 + 8 * fq;
                u32x4 w; w.x = cvtpk(mg[mm][0].x, mg[mm][0].y); w.y = cvtpk(mg[mm][0].z, mg[mm][0].w); w.z = cvtpk(mg[mm][1].x, mg[mm][1].y); w.w = cvtpk(mg[mm][1].z, mg[mm][1].w);
                *(u32x4*)(F.XN + (size_t)row * D + col) = w; mg[mm][0] = (f32x4){0.f, 0.f, 0.f, 0.f}; mg[mm][1] = (f32x4){0.f, 0.f, 0.f, 0.f};
            }
        }
        asm volatile("s_waitcnt lgkmcnt(0)" ::: "memory");
    }
    asm volatile("s_waitcnt vmcnt(0)" ::: "memory"); __syncthreads();
#undef BR_GATE
#undef BR_STAGE
#undef BR_UNIT
}
#ifndef PROBE_ST
#define PROBE_ST -1
#endif
#define LPHASE(st, ...) do { if (PROBE_ST == (st)) { { const int probe_rep = 1; (void)probe_rep; __VA_ARGS__ } GRID_BARRIER(); } PHASE(B0 + (st), __VA_ARGS__); } while (0)
__device__ __forceinline__ void ph_lora(Frame& F, int l) {
    pg8::Gemm g{F.XN, (const bf16*)(F.ws + WS_WL), M, 1280, 512, 512, 512}; pg8::StaticOrder S; S.init(M, 1280, F.G, F.bid);
    pg8::EpiFeat E{F.FEAT, F.in[I_W0] + l * 512, F.in[I_A0] + l * 512};
    pg8::gemm_phase<pg8::EpiFeat>(F.lds, F.tid, g, S, E);
}
template <int L>
__device__ __forceinline__ void run_layer(LAS unsigned char* lds_raw, const int wave0, const int ph_lo, const int ph_hi) {
    constexpr int B0 = 2 + 10 * L;
    LPHASE(0, MKFRAME(); ph_swiglu(F, L, 0); ph_res(F, L, 0, L == 0););
    LPHASE(1, MKFRAME(); ph_p(F); ph_p_conv(F, L););
    LPHASE(2, MKFRAME(); pre_phase(F, L););
    LPHASE(3, MKFRAME(); ph_lora(F, L););
    LPHASE(4, MKFRAME(); scan_phase(F, L, L + 2 * probe_rep););
    LPHASE(5, MKFRAME(); post_phase(F, L););
    LPHASE(6, MKFRAME(); ph_branch(F););
    LPHASE(7, MKFRAME(); ph_res(F, L, 1, false); if (L == 0) conv_idle(F, 1, 2, 0););
    LPHASE(8, MKFRAME(); ph_swiglu(F, L, 1); ph_res(F, L, 2, false); if (L == 0) conv_idle(F, 1, 3, 1););
}

__global__ void __launch_bounds__(512, 2) mega_fwd(Args a) {
    extern __shared__ __attribute__((aligned(16))) unsigned char lds_raw_[];
    LAS unsigned char* lds_raw = (LAS unsigned char*)lds_raw_;
    cg::grid_group grid = cg::this_grid();
    const int ph_lo = a.ph_lo, ph_hi = a.ph_hi;
    const int wave0 = __builtin_amdgcn_readfirstlane((int)(threadIdx.x >> 6));
    {
        volatile LAS unsigned* st0 = (volatile LAS unsigned*)(lds_raw + MISC_OFF + 32);
        if (threadIdx.x < 2) st0[threadIdx.x] = 0u;
        __syncthreads();
        if (threadIdx.x == 0) (void)xb_add((unsigned*)(a.ws + WS_CTL) + CW_BAR + XB_XCNT(xb_xcc_id()), 1u);
    }
    if (ph_hi > 100000) grid.sync();
    PHASE(0, MKFRAME(); phase0(F););
    PHASE(1, MKFRAME(); norm_phase(F, 0, 0, false, false););
    run_layer<0>(lds_raw, wave0, ph_lo, ph_hi);
    run_layer<1>(lds_raw, wave0, ph_lo, ph_hi);
}

extern "C" void kernel_launch(void* const* d_in, const int* in_sizes, int n_in, void* d_out, int out_size, void* d_ws, size_t ws_size, hipStream_t stream) {
    static int grid = 0;
    if (grid == 0) {
        if (n_in != N_INPUTS || (size_t)out_size != O_END || ws_size < WS_END) { fprintf(stderr, "kernel_launch: unexpected shapes: n_in %d out %d ws %zu (need %zu)\n", n_in, out_size, ws_size, (size_t)WS_END); grid = -1; return; }
        int dev = 0, cus = 0, per_cu = 0;
        hipGetDevice(&dev); hipDeviceGetAttribute(&cus, hipDeviceAttributeMultiprocessorCount, dev);
        if (hipFuncSetAttribute((const void*)mega_fwd, hipFuncAttributeMaxDynamicSharedMemorySize, LDS_BYTES) != hipSuccess) { fprintf(stderr, "kernel_launch: hipFuncSetAttribute failed\n"); grid = -1; return; }
        if (hipOccupancyMaxActiveBlocksPerMultiprocessor(&per_cu, (const void*)mega_fwd, 512, LDS_BYTES) != hipSuccess || per_cu < 1) { fprintf(stderr, "kernel_launch: occupancy query says %d\n", per_cu); per_cu = 1; }
        (void)hipGetLastError();
        grid = cus * 1;
        fprintf(stderr, "kernel_launch: cus %d per_cu %d grid %d ws %zu\n", cus, per_cu, grid, ws_size);
    }
    if (grid < 0) return;
    hipMemsetAsync((char*)d_ws + WS_CTL, 0, CTL_BYTES, stream);
    Args a{};
    for (int i = 0; i < N_INPUTS; ++i) a.in[i] = (const float*)d_in[i];
    a.out = (float*)d_out; a.ws = (unsigned char*)d_ws;
#ifndef MK_SPLIT
    a.ph_lo = 0; a.ph_hi = NPH;
    void* args[] = {&a};
    hipError_t e = hipLaunchCooperativeKernel((const void*)mega_fwd, dim3(grid), dim3(512), args, LDS_BYTES, stream);
    if (e != hipSuccess) fprintf(stderr, "kernel_launch: cooperative launch failed: %s\n", hipGetErrorString(e));
#else
    for (int ph = 0; ph < NPH; ++ph) {
        a.ph_lo = ph; a.ph_hi = ph + 1;
        void* args[] = {&a};
        hipError_t e = hipLaunchCooperativeKernel((const void*)mega_fwd, dim3(grid), dim3(512), args, LDS_BYTES, stream);
        if (e != hipSuccess) { fprintf(stderr, "kernel_launch: launch %d failed: %s\n", ph, hipGetErrorString(e)); break; }
    }
#endif
}
```
